# Optimizing an MI355X kernel written in HIP

```python
import jax, jax.numpy as jnp
from jax import lax
import numpy as np

D_MODEL = 1024
BATCH = 2
SEQ = 8192
DEPTH = 2
DEC_BATCH = 8
DEC_SEQ = 64
PAST_LEN = 4096

CHUNK = 64
Q_BLOCK = 128
ROPE_THETA = 500000.0
RMS_EPS = 1e-6
NEG_INF = -1e30

N_AB_LAYERS = (DEPTH + 1) // 2
N_C_LAYERS = DEPTH // 2

A_HEADS = 8
A_NOPE = 64
A_ROPE = 32
A_QK = A_NOPE + A_ROPE
A_V = 64
A_Q_RANK = 384
A_KV_RANK = 256
A_WIDTH = A_HEADS * A_V
A_SCALE = A_QK ** -0.5

B_HEADS = 8
B_HEAD_DIM = 64
B_WIDTH = B_HEADS * B_HEAD_DIM
B_PAST_CHUNKS = 8
B_BAND = B_PAST_CHUNKS * CHUNK
B_MAX_REL = 128
B_SCALE = B_HEAD_DIM ** -0.5

C_HEADS = 16
C_KV_HEADS = 2
C_GROUP = C_HEADS // C_KV_HEADS
C_HEAD_DIM = 64
C_WIDTH = C_HEADS * C_HEAD_DIM
C_WINDOW = 128
C_PAST_CHUNKS = C_WINDOW // CHUNK
C_ROT = C_HEAD_DIM // 4
C_SCALE = C_HEAD_DIM ** -0.5

AB_SIZES = (A_Q_RANK, A_KV_RANK, A_ROPE, A_WIDTH, B_WIDTH, B_WIDTH, B_WIDTH, B_WIDTH)
AB_IN = A_Q_RANK + A_KV_RANK + A_ROPE + A_WIDTH + 4 * B_WIDTH
C_SIZES = (C_WIDTH, C_KV_HEADS * C_HEAD_DIM, C_KV_HEADS * C_HEAD_DIM, C_WIDTH)
C_IN = 2 * C_WIDTH + 2 * C_KV_HEADS * C_HEAD_DIM

kernel_name = 'hybrid_chunk_stream_encoder_step'


def _split(z, sizes):
    idx, acc = [], 0
    for n in sizes[:-1]:
        acc += n
        idx.append(acc)
    return jnp.split(z, idx, axis=-1)


def _rms(x, g):
    xf = x.astype(jnp.float32)
    y = xf * lax.rsqrt(jnp.mean(xf * xf, axis=-1, keepdims=True) + RMS_EPS)
    return (y * g.astype(jnp.float32)).astype(x.dtype)


def _rope(x, pos, rot):
    half = rot // 2
    inv = jnp.power(ROPE_THETA, -jnp.arange(half, dtype=jnp.float32) * 2.0 / rot)
    ang = pos.astype(jnp.float32)[:, None] * inv[None, :]
    cos = jnp.cos(ang)[:, None, :].astype(x.dtype)
    sin = jnp.sin(ang)[:, None, :].astype(x.dtype)
    x1, x2 = x[..., :half], x[..., half:rot]
    return jnp.concatenate([x1 * cos - x2 * sin, x2 * cos + x1 * sin, x[..., rot:]], axis=-1)


def _grouped_attend(q, k, v, valid, scale, bias=None, sinks=None):
    s = jnp.einsum('...qhgd,...khd->...hgqk', q, k).astype(jnp.float32) * scale
    if bias is not None:
        s = s + bias.astype(jnp.float32)
    s = jnp.where(valid, s, NEG_INF)
    if sinks is not None:
        hk, g = q.shape[-3], q.shape[-2]
        sk = jnp.broadcast_to(sinks.astype(jnp.float32).reshape(hk, g, 1, 1), s.shape[:-1] + (1,))
        p = jax.nn.softmax(jnp.concatenate([s, sk], axis=-1), axis=-1)[..., :-1]
    else:
        p = jax.nn.softmax(s, axis=-1)
    return jnp.einsum('...hgqk,...khd->...qhgd', p.astype(v.dtype), v)


def _rel_bias(table, rel):
    idx = jnp.clip(rel, -B_MAX_REL, B_MAX_REL) + B_MAX_REL
    return jnp.expand_dims(jnp.moveaxis(table[:, idx], 0, -3), -3)


def _band_gather(k, n_past):
    b, s = k.shape[:2]
    nc = s // CHUNK
    kc = k.reshape((b, nc, CHUNK) + k.shape[2:])
    kp = jnp.pad(kc, [(0, 0), (n_past, 0)] + [(0, 0)] * (kc.ndim - 2))
    idx = jnp.arange(nc)[:, None] + jnp.arange(n_past + 1)[None, :]
    band = kp[:, idx]
    return band.reshape((b, nc, (n_past + 1) * CHUNK) + k.shape[2:])


def _band_prompt(q, k, v, n_past, scale, rel_table=None, sinks=None):
    b, s = q.shape[:2]
    nc = s // CHUNK
    band = (n_past + 1) * CHUNK
    qc = q.reshape((b, nc, CHUNK) + q.shape[2:])
    kb, vb = _band_gather(k, n_past), _band_gather(v, n_past)
    kpos = (jnp.arange(nc)[:, None] - n_past) * CHUNK + jnp.arange(band)[None, :]
    qpos = jnp.arange(nc)[:, None] * CHUNK + jnp.arange(CHUNK)[None, :]
    valid = (kpos >= 0)[:, None, None, None, :]
    bias = None
    if rel_table is not None:
        bias = _rel_bias(rel_table, qpos[:, :, None] - kpos[:, None, :])
    o = _grouped_attend(qc, kb, vb, valid, scale, bias, sinks)
    return o.reshape(b, s, -1)


def _band_sample(q, k_new, v_new, k_buf, v_buf, pos, scale, rel_table=None, sinks=None):
    b, t = q.shape[:2]
    w = k_buf.shape[1]
    k = jnp.concatenate([k_buf, k_new], axis=1)
    v = jnp.concatenate([v_buf, v_new], axis=1)
    kpos = jnp.concatenate([pos[0] - w + jnp.arange(w), pos])
    bias = None
    if rel_table is not None:
        bias = _rel_bias(rel_table, pos[:, None] - kpos[None, :])
    o = _grouped_attend(q, k, v, jnp.asarray(True), scale, bias, sinks)
    return o.reshape(b, t, -1), k[:, -w:], v[:, -w:]


def _mla_keys(c, kr, w_ukv):
    kv = jnp.einsum('bkr,rhe->bkhe', c, w_ukv.reshape(A_KV_RANK, A_HEADS, A_NOPE + A_V))
    k = jnp.concatenate([kv[..., :A_NOPE], jnp.broadcast_to(kr[:, :, None, :], kv.shape[:3] + (A_ROPE,))], axis=-1)
    return k, kv[..., A_NOPE:]


def _mla_prompt(q, k, v):
    b, s = q.shape[:2]
    kchunk = jnp.arange(s) // CHUNK

    def blk(i):
        qs = i * Q_BLOCK
        qb = lax.dynamic_slice_in_dim(q, qs, Q_BLOCK, axis=1)[:, :, :, None, :]
        qchunk = (qs + jnp.arange(Q_BLOCK)) // CHUNK
        mask = kchunk[None, :] <= qchunk[:, None]
        return _grouped_attend(qb, k, v, mask, A_SCALE)

    o = lax.map(blk, jnp.arange(s // Q_BLOCK))
    return jnp.moveaxis(o, 0, 1).reshape(b, s, A_WIDTH)


def _ab_layer(h, pos, cache, pre_g, post_g, w_in, q_norm, kv_norm, w_uq, w_ukv, rel_table, w_out):
    b, s, _ = h.shape
    xn = _rms(h, pre_g)
    q_lat, c_kv, k_r, g_a, q_b, k_b, v_b, g_b = _split(xn @ w_in, AB_SIZES)
    qa = (_rms(q_lat, q_norm) @ w_uq).reshape(b, s, A_HEADS, A_QK)
    qa = jnp.concatenate([qa[..., :A_NOPE], _rope(qa[..., A_NOPE:], pos, A_ROPE)], axis=-1)
    c_new = _rms(c_kv, kv_norm)
    kr_new = _rope(k_r[:, :, None, :], pos, A_ROPE)[:, :, 0]
    q_b = q_b.reshape(b, s, B_HEADS, 1, B_HEAD_DIM)
    k_b = k_b.reshape(b, s, B_HEADS, B_HEAD_DIM)
    v_b = v_b.reshape(b, s, B_HEADS, B_HEAD_DIM)
    if cache is None:
        ka, va = _mla_keys(c_new, kr_new, w_ukv)
        o_a = _mla_prompt(qa, ka, va)
        o_b = _band_prompt(q_b, k_b, v_b, B_PAST_CHUNKS, B_SCALE, rel_table=rel_table)
        wb = min(B_BAND, s)
        state = (c_new, kr_new, k_b[:, s - wb:], v_b[:, s - wb:])
    else:
        ckv_c, kr_c, bk_c, bv_c = cache
        ka, va = _mla_keys(jnp.concatenate([ckv_c, c_new], axis=1), jnp.concatenate([kr_c, kr_new], axis=1), w_ukv)
        o_a = _grouped_attend(qa[:, :, :, None, :], ka, va, jnp.asarray(True), A_SCALE).reshape(b, s, A_WIDTH)
        o_b, bk, bv = _band_sample(q_b, k_b, v_b, bk_c, bv_c, pos, B_SCALE, rel_table=rel_table)
        state = (c_new, kr_new, bk, bv)
    mixed = jnp.concatenate([o_a * jax.nn.silu(g_a), o_b * jax.nn.silu(g_b)], axis=-1)
    return h + _rms(mixed @ w_out, post_g), state


def _c_layer(h, pos, cache, pre_g, post_g, w_in, sinks, w_out):
    b, s, _ = h.shape
    xn = _rms(h, pre_g)
    q, k, v, g = _split(xn @ w_in, C_SIZES)
    q = _rope(q.reshape(b, s, C_HEADS, C_HEAD_DIM), pos, C_ROT).reshape(b, s, C_KV_HEADS, C_GROUP, C_HEAD_DIM)
    k = _rope(k.reshape(b, s, C_KV_HEADS, C_HEAD_DIM), pos, C_ROT)
    v = v.reshape(b, s, C_KV_HEADS, C_HEAD_DIM)
    if cache is None:
        o = _band_prompt(q, k, v, C_PAST_CHUNKS, C_SCALE, sinks=sinks)
        w = min(C_WINDOW, s)
        state = (k[:, s - w:], v[:, s - w:])
    else:
        o, kc, vc = _band_sample(q, k, v, cache[0], cache[1], pos, C_SCALE, sinks=sinks)
        state = (kc, vc)
    return h + _rms((o * jax.nn.silu(g)) @ w_out, post_g), state


def setup_inputs(seed: int = 0) -> dict:
    key = jax.random.key(seed)
    ks = jax.random.split(key, 22)
    f32 = jnp.float32

    def nrm(k, shape, scale=1.0):
        return jax.random.normal(k, shape, f32) * scale

    def gain(k, shape):
        return 1.0 + 0.02 * jax.random.normal(k, shape, f32)

    wb = min(B_BAND, PAST_LEN)
    wc = min(C_WINDOW, PAST_LEN)
    return {
        'x_prompt': nrm(ks[0], (BATCH, SEQ, D_MODEL)),
        'x_sample': nrm(ks[1], (DEC_BATCH, DEC_SEQ, D_MODEL)),
        'cache_a_ckv': nrm(ks[2], (N_AB_LAYERS, DEC_BATCH, PAST_LEN, A_KV_RANK)),
        'cache_a_krope': nrm(ks[3], (N_AB_LAYERS, DEC_BATCH, PAST_LEN, A_ROPE)),
        'cache_b_k': nrm(ks[4], (N_AB_LAYERS, DEC_BATCH, wb, B_HEADS, B_HEAD_DIM)),
        'cache_b_v': nrm(ks[5], (N_AB_LAYERS, DEC_BATCH, wb, B_HEADS, B_HEAD_DIM)),
        'cache_c_k': nrm(ks[6], (N_C_LAYERS, DEC_BATCH, wc, C_KV_HEADS, C_HEAD_DIM)),
        'cache_c_v': nrm(ks[7], (N_C_LAYERS, DEC_BATCH, wc, C_KV_HEADS, C_HEAD_DIM)),
        'ab_pre_norm': gain(ks[8], (N_AB_LAYERS, D_MODEL)),
        'ab_post_norm': gain(ks[9], (N_AB_LAYERS, D_MODEL)),
        'ab_w_in': nrm(ks[10], (N_AB_LAYERS, D_MODEL, AB_IN), D_MODEL ** -0.5),
        'ab_q_norm': gain(ks[11], (N_AB_LAYERS, A_Q_RANK)),
        'ab_kv_norm': gain(ks[12], (N_AB_LAYERS, A_KV_RANK)),
        'ab_w_uq': nrm(ks[13], (N_AB_LAYERS, A_Q_RANK, A_HEADS * A_QK), A_Q_RANK ** -0.5),
        'ab_w_ukv': nrm(ks[14], (N_AB_LAYERS, A_KV_RANK, A_HEADS * (A_NOPE + A_V)), A_KV_RANK ** -0.5),
        'ab_rel_bias': nrm(ks[15], (N_AB_LAYERS, B_HEADS, 2 * B_MAX_REL + 1), 0.1),
        'ab_w_out': nrm(ks[16], (N_AB_LAYERS, A_WIDTH + B_WIDTH, D_MODEL), (A_WIDTH + B_WIDTH) ** -0.5),
        'c_pre_norm': gain(ks[17], (N_C_LAYERS, D_MODEL)),
        'c_post_norm': gain(ks[18], (N_C_LAYERS, D_MODEL)),
        'c_w_in': nrm(ks[19], (N_C_LAYERS, D_MODEL, C_IN), D_MODEL ** -0.5),
        'c_sinks': nrm(ks[20], (N_C_LAYERS, C_HEADS), 0.5),
        'c_w_out': nrm(ks[21], (N_C_LAYERS, C_WIDTH, D_MODEL), C_WIDTH ** -0.5),
    }


def reference(x_prompt, x_sample, cache_a_ckv, cache_a_krope, cache_b_k, cache_b_v, cache_c_k, cache_c_v,
              ab_pre_norm, ab_post_norm, ab_w_in, ab_q_norm, ab_kv_norm, ab_w_uq, ab_w_ukv, ab_rel_bias, ab_w_out,
              c_pre_norm, c_post_norm, c_w_in, c_sinks, c_w_out):
    past_len = cache_a_ckv.shape[2]
    pos_p = jnp.arange(x_prompt.shape[1], dtype=jnp.int32)
    pos_s = past_len + jnp.arange(x_sample.shape[1], dtype=jnp.int32)
    hp, hs = x_prompt, x_sample
    ab_p, ab_s, c_p, c_s = [], [], [], []
    for layer in range(DEPTH):
        i = layer // 2
        if layer % 2 == 0:
            w = (ab_pre_norm[i], ab_post_norm[i], ab_w_in[i], ab_q_norm[i], ab_kv_norm[i],
                 ab_w_uq[i], ab_w_ukv[i], ab_rel_bias[i], ab_w_out[i])
            hp, st = _ab_layer(hp, pos_p, None, *w)
            ab_p.append(st)
            hs, st = _ab_layer(hs, pos_s, (cache_a_ckv[i], cache_a_krope[i], cache_b_k[i], cache_b_v[i]), *w)
            ab_s.append(st)
        else:
            w = (c_pre_norm[i], c_post_norm[i], c_w_in[i], c_sinks[i], c_w_out[i])
            hp, st = _c_layer(hp, pos_p, None, *w)
            c_p.append(st)
            hs, st = _c_layer(hs, pos_s, (cache_c_k[i], cache_c_v[i]), *w)
            c_s.append(st)

    def stk(states, j):
        return jnp.stack([st[j] for st in states])

    return (hp, hs,
            stk(ab_p, 0), stk(ab_p, 1), stk(ab_p, 2), stk(ab_p, 3), stk(c_p, 0), stk(c_p, 1),
            stk(ab_s, 0), stk(ab_s, 1), stk(ab_s, 2), stk(ab_s, 3), stk(c_s, 0), stk(c_s, 1))
```

```cpp
#include <hip/hip_runtime.h>
#include <hip/hip_cooperative_groups.h>
#include <cstdio>
#include <cstdint>
#include <cmath>
namespace cg = cooperative_groups;

#define LAS __attribute__((address_space(3)))
#define GAS __attribute__((address_space(1)))
typedef unsigned short bf16_t;
typedef short bf16x8 __attribute__((ext_vector_type(8)));
typedef short s16x4 __attribute__((ext_vector_type(4)));
typedef float f32x4 __attribute__((ext_vector_type(4)));
typedef float f32x2 __attribute__((ext_vector_type(2)));
typedef float f32x16 __attribute__((ext_vector_type(16)));
typedef unsigned u32x4 __attribute__((ext_vector_type(4)));
typedef unsigned u32x2 __attribute__((ext_vector_type(2)));
typedef __bf16 bf16x2_t __attribute__((ext_vector_type(2)));

constexpr int MP = 16384, MS = 512, MT = MP + MS;
constexpr int DM = 1024;
constexpr int ZP = 3328;
constexpr int Z1P = 2304;
constexpr int ZC_CKV = 384, ZC_KR = 640, ZC_GA = 704, ZC_QB = 1216, ZC_KB = 1728, ZC_VB = 2240, ZC_GB = 2752;
constexpr int Z1_K = 1024, Z1_V = 1152, Z1_G = 1280;
constexpr float LOG2E = 1.4426950408889634f;
constexpr float A_SC = 0.10206207261596575f * LOG2E;
constexpr float B_SC = 0.125f * LOG2E;
constexpr float C_SC = 0.125f * LOG2E;
constexpr float RMS_EPS = 1e-6f;
constexpr size_t O_Y = 0, O_CKV_P = 17301504, O_KR_P = 21495808, O_BK_P = 22020096, O_BV_P = 22544384, O_CK_P = 23068672, O_CV_P = 23101440,
                 O_CKV_S = 23134208, O_KR_S = 23265280, O_BK_S = 23281664, O_BV_S = 25378816, O_CK_S = 27475968, O_CV_S = 27607040;
constexpr size_t KiB = 1024, MiB = 1024 * 1024;
constexpr size_t WS_CTL = 0, WS_ROPEA = 64 * KiB, WS_ROPEC = 64 * KiB + 1 * MiB, WS_WIN0 = 2 * MiB, WS_WUQ = 8 * MiB + 512 * KiB, WS_WUKV = 9 * MiB + 256 * KiB,
                 WS_WOUT0 = 10 * MiB, WS_WIN1 = 12 * MiB, WS_WOUT1 = 16 * MiB + 512 * KiB, WS_KCS = 18 * MiB + 512 * KiB, WS_VCS = WS_KCS + 384 * KiB,
                 WS_Z = 20 * MiB, WS_KVB = 128 * MiB, WS_CACHEC = 225 * MiB, WS_KRC = 241 * MiB, WS_KBS = 243 * MiB, WS_VBS = 247 * MiB + 512 * KiB,
                 WS_Y = 128 * MiB, WS_H1 = 161 * MiB  , WS_XN1 = 194 * MiB, WS_YP = 228 * MiB  , WS_END = 252 * MiB;
constexpr size_t DO_XN0 = 0, DO_QA = 34 * MiB;

__device__ __forceinline__ unsigned pk2(float lo, float hi) { f32x2 v = {lo, hi}; bf16x2_t b = __builtin_convertvector(v, bf16x2_t); return __builtin_bit_cast(unsigned, b); }
__device__ __forceinline__ float bflo(unsigned w) { return __uint_as_float(w << 16); }
__device__ __forceinline__ float bfhi(unsigned w) { return __uint_as_float(w & 0xffff0000u); }
__device__ __forceinline__ float wave_sum(float v) {
#pragma unroll
    for (int o = 1; o < 64; o <<= 1) v += __shfl_xor(v, o);
    return v;
}
__device__ __forceinline__ float silu_f(float x) { return x * __builtin_amdgcn_rcpf(1.0f + __builtin_amdgcn_exp2f(-x * LOG2E)); }
__device__ __forceinline__ int row_pos(int row) { return row < MP ? (row & 8191) : 4096 + ((row - MP) & 63); }

namespace pg8 {
constexpr int BM = 256, BK = 64, HALF = 128, HTB = HALF * BK * 2, STAGE_BYTES = 8 * HTB, NXCD = 8, WGM = 8;
__host__ __device__ __forceinline__ int lds_byte(int r, int c) { const int st = (r >> 4) * 2 + (c >> 5), rr = r & 15, cc = c & 31, ob = rr * 64 + cc * 2; return st * 1024 + (ob ^ (((ob >> 9) & 1) << 5)); }
__host__ __device__ __forceinline__ void stage_rc(int b, int& R, int& C) { const int st = b / 1024, sb = b % 1024, swz = sb ^ (((sb >> 9) & 1) << 5); R = (st >> 1) * 16 + swz / 64; C = (st & 1) * 32 + (swz % 64) / 2; }
__host__ __device__ __forceinline__ int perm32(int rho) { const int n = rho >> 4, i = rho & 15; return 8 * (i >> 2) + 4 * n + (i & 3); }
struct Unit { int pm, pn; };
struct Gemm { const GAS bf16_t* A; const GAS bf16_t* Bt; int M, N, K, lda, ldb; };
struct StaticOrder {
    int nM, nN, nwg, G, c, one_pm, one_pn;
    __device__ void init(int M, int N, int G_, int c_) { nM = M / BM; nN = N / BM; nwg = nM * nN; G = G_; c = c_; one_pm = -1; one_pn = 0; }
    __device__ void init_one(int pm, int pn) { nM = nN = nwg = G = 1; c = 0; one_pm = pm; one_pn = pn; }
    __device__ bool next(int i, Unit& u) const {
        if (one_pm != -1) { if (i > 0 || one_pm < 0) return false; u.pm = one_pm; u.pn = one_pn; return true; }
        const long L = (long)i * G + c; if (L >= nwg) return false;
        int wgid = (int)L; { const int q = nwg / NXCD, r = nwg % NXCD, xcd = wgid % NXCD, off = wgid / NXCD; wgid = (xcd < r ? xcd * (q + 1) : r * (q + 1) + (xcd - r) * q) + off; }
        const int nig = WGM * nN, gid = wgid / nig, fm = gid * WGM, gsz = (nM - fm) < WGM ? (nM - fm) : WGM;
        u.pm = fm + ((wgid % nig) % gsz); u.pn = (wgid % nig) / gsz; return true;
    }
};
template <class Epi, bool ALIGN_EPI>
__device__ __forceinline__ void gemm_phase(LAS unsigned char* lds, const Gemm g, const StaticOrder& S, const Epi& E) {
    int tid = threadIdx.x; asm volatile("" : "+v"(tid));
    const int wid = __builtin_amdgcn_readfirstlane(tid >> 6), lane = tid & 63, wr = wid >> 2, wc = wid & 3, fr = lane & 15, fq = lane >> 4;
    const int K = g.K; int nt = K / BK; asm volatile("" : "+s"(nt));
    unsigned voffA[2], voffB[2];
#pragma unroll
    for (int i = 0; i < 2; ++i) { int R, C; stage_rc(tid * 16 + i * 8192, R, C); const int Rb = Epi::PERM ? ((R & ~31) + perm32(R & 31)) : R;
        voffA[i] = (unsigned)(R * g.lda + C) * 2u; voffB[i] = (unsigned)(Rb * g.ldb + C) * 2u; }
    const size_t kstep = (size_t)(BK * 2);
    const size_t hstepA = (size_t)HALF * g.lda * 2, hstepB = (size_t)HALF * g.ldb * 2;
    const size_t tstepA = 2 * hstepA, tstepB = 2 * hstepB;
    const unsigned ldsw = (unsigned)wid * 1024u;
    const int aoff = lds_byte(wr * 64 + fr, fq * 8), boff = lds_byte(wc * 32 + fr, fq * 8);
#define PG8_SA(b, h) (((b) * 2 + (h)) * HTB)
#define PG8_SB(b, h) ((4 + (b) * 2 + (h)) * HTB)
#define PG8_STAGE(bufoff, gbase, voff) do { _Pragma("unroll") for (int _i = 0; _i < 2; ++_i) \
        __builtin_amdgcn_global_load_lds((const GAS unsigned*)((const GAS char*)(gbase) + (voff)[_i]), (LAS unsigned*)(lds + (bufoff) + ldsw + _i * 8192), 16, 0, 0); } while (0)
#define PG8_LDA(dst, b, h) do { _Pragma("unroll") for (int m = 0; m < 4; ++m) _Pragma("unroll") for (int k = 0; k < 2; ++k) dst[m][k] = *(const LAS bf16x8*)(lds + PG8_SA(b, h) + aoff + m * 2048 + k * 1024); } while (0)
#define PG8_LDB(dst, b, h) do { _Pragma("unroll") for (int n = 0; n < 2; ++n) _Pragma("unroll") for (int k = 0; k < 2; ++k) dst[n][k] = *(const LAS bf16x8*)(lds + PG8_SB(b, h) + boff + n * 2048 + k * 1024); } while (0)
#define PG8_MMA(ai, bj, At, Bt) do { __builtin_amdgcn_s_setprio(1); _Pragma("unroll") for (int m = 0; m < 4; ++m) _Pragma("unroll") for (int n = 0; n < 2; ++n) _Pragma("unroll") for (int k = 0; k < 2; ++k) \
        acc[ai][bj][m][n] = __builtin_amdgcn_mfma_f32_16x16x32_bf16(Bt[n][k], At[m][k], acc[ai][bj][m][n], 0, 0, 0); __builtin_amdgcn_s_setprio(0); } while (0)
#define PG8_WAIT_V(n) asm volatile("s_waitcnt vmcnt(" #n ")" ::: "memory")
#define PG8_WAIT_L(n) asm volatile("s_waitcnt lgkmcnt(" #n ")" ::: "memory")
#define PG8_BAR __builtin_amdgcn_s_barrier()
#define PG8_SCHED __builtin_amdgcn_sched_barrier(0)
    Unit cur, nxt; int ui = 0;
    if (!S.next(0, cur)) return;
    f32x4 acc[2][2][4][2];
#pragma unroll
    for (int a = 0; a < 2; ++a)
#pragma unroll
        for (int b = 0; b < 2; ++b)
#pragma unroll
            for (int m = 0; m < 4; ++m)
#pragma unroll
                for (int n = 0; n < 2; ++n) acc[a][b][m][n] = (f32x4){0.f, 0.f, 0.f, 0.f};
    bf16x8 At[4][2], B0[2][2], B1[2][2];
    const GAS char* cA = (const GAS char*)g.A + (size_t)cur.pm * tstepA; const GAS char* cB = (const GAS char*)g.Bt + (size_t)cur.pn * tstepB;
    PG8_STAGE(PG8_SB(0, 0), cB, voffB); PG8_STAGE(PG8_SB(0, 1), cB + hstepB, voffB); PG8_STAGE(PG8_SA(0, 0), cA, voffA); PG8_STAGE(PG8_SA(0, 1), cA + hstepA, voffA);
    if (wr == 1) PG8_BAR;
    PG8_WAIT_V(2); PG8_BAR;
    PG8_STAGE(PG8_SB(1, 0), cB + kstep, voffB); PG8_STAGE(PG8_SA(1, 0), cA + kstep, voffA); PG8_STAGE(PG8_SB(1, 1), cB + hstepB + kstep, voffB);
    PG8_WAIT_V(6); PG8_BAR;
    for (;;) {
        const bool has_next = S.next(ui + 1, nxt);
        const GAS char* nA = has_next ? (const GAS char*)g.A + (size_t)nxt.pm * tstepA : cA; const GAS char* nB = has_next ? (const GAS char*)g.Bt + (size_t)nxt.pn * tstepB : cB;
#pragma unroll 1
        for (int t = 0; t < nt; t += 2) {
            const bool last = (t == nt - 2);
            const GAS char* a1 = cA + (size_t)(t + 1) * kstep;
            const GAS char* a2 = last ? nA : cA + (size_t)(t + 2) * kstep; const GAS char* b2 = last ? nB : cB + (size_t)(t + 2) * kstep;
            const GAS char* a3 = a2 + kstep; const GAS char* b3 = b2 + kstep;
            PG8_LDB(B0, 0, 0); PG8_LDB(B1, 0, 1); PG8_SCHED; PG8_LDA(At, 0, 0); PG8_STAGE(PG8_SA(1, 1), a1 + hstepA, voffA);
            PG8_WAIT_V(8); PG8_WAIT_L(0); PG8_BAR; PG8_MMA(0, 0, At, B0); PG8_MMA(0, 1, At, B1); PG8_BAR; PG8_SCHED;
            PG8_LDA(At, 0, 1); PG8_STAGE(PG8_SB(0, 0), b2, voffB); PG8_STAGE(PG8_SB(0, 1), b2 + hstepB, voffB); PG8_STAGE(PG8_SA(0, 0), a2, voffA);
            PG8_WAIT_V(8); PG8_WAIT_L(0); PG8_BAR; PG8_MMA(1, 0, At, B0); PG8_MMA(1, 1, At, B1); PG8_BAR; PG8_SCHED;
            PG8_LDB(B0, 1, 0); PG8_LDB(B1, 1, 1); PG8_SCHED; PG8_LDA(At, 1, 0); PG8_STAGE(PG8_SA(0, 1), a2 + hstepA, voffA);
            PG8_WAIT_V(8); PG8_WAIT_L(0); PG8_BAR; PG8_MMA(0, 0, At, B0); PG8_MMA(0, 1, At, B1); PG8_BAR; PG8_SCHED;
            PG8_LDA(At, 1, 1); PG8_STAGE(PG8_SB(1, 0), b3, voffB); PG8_STAGE(PG8_SB(1, 1), b3 + hstepB, voffB); PG8_STAGE(PG8_SA(1, 0), a3, voffA);
            PG8_WAIT_V(8); PG8_WAIT_L(0); PG8_BAR; PG8_MMA(1, 0, At, B0); PG8_MMA(1, 1, At, B1); PG8_BAR; PG8_SCHED;
        }
        if constexpr (ALIGN_EPI) { if (wr == 0) PG8_BAR; }
        E(acc, cur, wr, wc, fr, fq);
        if (!has_next) break;
#pragma unroll
        for (int a = 0; a < 2; ++a)
#pragma unroll
            for (int b = 0; b < 2; ++b)
#pragma unroll
                for (int m = 0; m < 4; ++m)
#pragma unroll
                    for (int n = 0; n < 2; ++n) acc[a][b][m][n] = (f32x4){0.f, 0.f, 0.f, 0.f};
        cur = nxt; cA = nA; cB = nB; ++ui;
        if constexpr (ALIGN_EPI) { if (wr == 1) PG8_BAR; }
    }
    PG8_WAIT_V(0);
    if constexpr (!ALIGN_EPI) { if (wr == 0) PG8_BAR; }
    PG8_BAR;
#undef PG8_SA
#undef PG8_SB
#undef PG8_STAGE
#undef PG8_LDA
#undef PG8_LDB
#undef PG8_MMA
#undef PG8_WAIT_V
#undef PG8_WAIT_L
#undef PG8_BAR
#undef PG8_SCHED
}

struct EpiF32 {
    static constexpr bool PERM = false;
    GAS float* O; int ldc;
    __device__ __forceinline__ void operator()(const f32x4 (&acc)[2][2][4][2], const Unit& u, int wr, int wc, int fr, int fq) const {
#pragma unroll
        for (int ai = 0; ai < 2; ++ai)
#pragma unroll
            for (int m = 0; m < 4; ++m) { GAS float* rowp = O + (size_t)(u.pm * BM + ai * HALF + wr * 64 + m * 16 + fr) * ldc + u.pn * BM + wc * 32 + 4 * fq;
#pragma unroll
                for (int bj = 0; bj < 2; ++bj)
#pragma unroll
                    for (int n = 0; n < 2; ++n) *(GAS f32x4*)(rowp + bj * HALF + n * 16) = acc[ai][bj][m][n]; }
    }
};
enum { M_ID = 0, M_SCALE = 1, M_SILU = 2, M_ROPE32 = 3, M_ROPE16 = 4, M_SKIP = 5 };
template <int KIND> struct EpiStrip {
    static constexpr bool PERM = true;
    GAS bf16_t* O; int ldc; const GAS f32x4* ropeA; const GAS f32x4* ropeC; GAS float* dout; GAS bf16_t* kcs; GAS bf16_t* vcs;
    __device__ __forceinline__ void operator()(const f32x4 (&acc)[2][2][4][2], const Unit& u, int wr, int wc, int fr, int fq) const {
#pragma unroll
        for (int bj = 0; bj < 2; ++bj) {
            const int cs = u.pn * BM + bj * HALF + wc * 32;
            const int s = cs >> 5;
            int mode = M_ID; float scale = 1.f;
            if (KIND == 0) { if (s == 20) mode = M_ROPE32; else if (s == 21) mode = M_SKIP; else if ((s >= 22 && s < 38) || (s >= 86 && s < 102)) mode = M_SILU; else if (s >= 38 && s < 54) { mode = M_SCALE; scale = B_SC; } else if (s >= 102) mode = M_SKIP; }
            if (KIND == 1) { scale = A_SC; mode = (s % 3 == 2) ? M_ROPE32 : M_SCALE; }
            if (KIND == 3) { if (s < 32) { scale = C_SC; mode = (s & 1) ? M_SCALE : M_ROPE16; } else if (s < 36) { mode = (s & 1) ? M_ID : M_ROPE16; } else if (s < 40) mode = M_ID; else mode = M_SILU; }
            if (mode == M_SKIP) continue;
            const int c0 = cs + 8 * fq;
#pragma unroll
            for (int ai = 0; ai < 2; ++ai)
#pragma unroll
                for (int m = 0; m < 4; ++m) {
                    const int row = u.pm * BM + ai * HALF + wr * 64 + m * 16 + fr;
                    f32x4 v0 = acc[ai][bj][m][0], v1 = acc[ai][bj][m][1];
                    if (mode == M_SILU) {
#pragma unroll
                        for (int i = 0; i < 4; ++i) { v0[i] = silu_f(v0[i]); v1[i] = silu_f(v1[i]); }
                    } else if (mode == M_ROPE32) {
                        const int pos = row_pos(row);
                        const GAS f32x4* tp = ropeA + (size_t)pos * 8 + (fq & 1) * 4;
                        const f32x4 t0 = tp[0], t1 = tp[1], t2 = tp[2], t3 = tp[3];
                        const float sg = (fq < 2) ? -1.f : 1.f;
                        f32x4 p0, p1;
#pragma unroll
                        for (int i = 0; i < 4; ++i) { p0[i] = __shfl_xor(v0[i], 32); p1[i] = __shfl_xor(v1[i], 32); }
                        v0[0] = v0[0] * t0[0] + sg * p0[0] * t0[1]; v0[1] = v0[1] * t0[2] + sg * p0[1] * t0[3];
                        v0[2] = v0[2] * t1[0] + sg * p0[2] * t1[1]; v0[3] = v0[3] * t1[2] + sg * p0[3] * t1[3];
                        v1[0] = v1[0] * t2[0] + sg * p1[0] * t2[1]; v1[1] = v1[1] * t2[2] + sg * p1[1] * t2[3];
                        v1[2] = v1[2] * t3[0] + sg * p1[2] * t3[1]; v1[3] = v1[3] * t3[2] + sg * p1[3] * t3[3];
                    } else if (mode == M_ROPE16) {
                        const int pos = row_pos(row);
                        const GAS f32x4* tp = ropeC + (size_t)pos * 4;
                        const f32x4 t0 = tp[0], t1 = tp[1], t2 = tp[2], t3 = tp[3];
                        const float sg = (fq == 0) ? -1.f : 1.f;
                        f32x4 p0, p1;
#pragma unroll
                        for (int i = 0; i < 4; ++i) { p0[i] = __shfl_xor(v0[i], 16); p1[i] = __shfl_xor(v1[i], 16); }
                        if (fq < 2) {
                            v0[0] = v0[0] * t0[0] + sg * p0[0] * t0[1]; v0[1] = v0[1] * t0[2] + sg * p0[1] * t0[3];
                            v0[2] = v0[2] * t1[0] + sg * p0[2] * t1[1]; v0[3] = v0[3] * t1[2] + sg * p0[3] * t1[3];
                            v1[0] = v1[0] * t2[0] + sg * p1[0] * t2[1]; v1[1] = v1[1] * t2[2] + sg * p1[1] * t2[3];
                            v1[2] = v1[2] * t3[0] + sg * p1[2] * t3[1]; v1[3] = v1[3] * t3[2] + sg * p1[3] * t3[3];
                        }
                    }
                    if (KIND == 3 && s >= 32 && s < 40) {
                        const int ck = c0 - Z1_K;
                        const bool isv = ck >= 128; const int cc = isv ? ck - 128 : ck;
                        if (row >= MP) {
                            const int bs = (row - MP) >> 6, t = (row - MP) & 63;
                            GAS float* dp = dout + (isv ? O_CV_S : O_CK_S) + ((size_t)bs * 128 + 64 + t) * 128 + cc;
                            *(GAS f32x4*)dp = v0; *(GAS f32x4*)(dp + 4) = v1;
                            GAS bf16_t* bp = (isv ? vcs : kcs) + ((size_t)bs * 192 + 128 + t) * 128 + cc;
                            u32x4 w; w.x = pk2(v0[0], v0[1]); w.y = pk2(v0[2], v0[3]); w.z = pk2(v1[0], v1[1]); w.w = pk2(v1[2], v1[3]);
                            *(GAS u32x4*)bp = w;
                        } else if ((row & 8191) >= 8064) {
                            const int b = row >> 13, p = (row & 8191) - 8064;
                            GAS float* dp = dout + (isv ? O_CV_P : O_CK_P) + ((size_t)b * 128 + p) * 128 + cc;
                            *(GAS f32x4*)dp = v0; *(GAS f32x4*)(dp + 4) = v1;
                        }
                    }
                    if (mode == M_SCALE || ((mode == M_ROPE32 || mode == M_ROPE16) && scale != 1.f)) { v0 = v0 * scale; v1 = v1 * scale; }
                    u32x4 w; w.x = pk2(v0[0], v0[1]); w.y = pk2(v0[2], v0[3]); w.z = pk2(v1[0], v1[1]); w.w = pk2(v1[2], v1[3]);
                    *(GAS u32x4*)(O + (size_t)row * ldc + c0) = w;
                    asm volatile("" ::: "memory");
                }
        }
    }
};
}

namespace att {
constexpr int LDS_K0 = 0  , LDS_V0 = 49152  , LDS_BIAS = 81920, LDS_SCHED = 83968, LDS_OST = 86016  , OSTP = 144;
struct AUnit {
    int t_lo, t_hi, t_split;
    const GAS bf16_t *k1, *k2, *kr1, *kr2, *v1, *v2;
    int kpitch, krpitch1, krpitch2;
    bool wactive; int wt_lo, wt_hi;
    const GAS bf16_t* q; int qpitch;
    GAS bf16_t* o; const GAS bf16_t* g; int opitch;
    int qpos0, wchunk;
    float sink;
    int nostore;
};
__device__ __forceinline__ s16x4 vtr(const LAS char* p) { typedef short v4i16_t __attribute__((ext_vector_type(4))); return __builtin_bit_cast(s16x4, __builtin_amdgcn_ds_read_tr16_b64_v4i16((LAS v4i16_t*)p)); }
__device__ __forceinline__ float xhalf_max(float m) { auto rr = __builtin_amdgcn_permlane32_swap(__float_as_uint(m), __float_as_uint(m), false, false); return fmaxf(__uint_as_float(rr[0]), __uint_as_float(rr[1])); }
__device__ __forceinline__ float xhalf_sum(float m) { auto rr = __builtin_amdgcn_permlane32_swap(__float_as_uint(m), __float_as_uint(m), false, false); return __uint_as_float(rr[0]) + __uint_as_float(rr[1]); }

__device__ __forceinline__ void glds16(const GAS void* gsrc, unsigned lds_dst) { unsigned keep;
    asm volatile("s_mov_b32 %0, m0\n\ts_mov_b32 m0, %2\n\ts_nop 0\n\tglobal_load_lds_dwordx4 %1, off\n\ts_mov_b32 m0, %0" : "=&s"(keep) : "v"(gsrc), "s"(lds_dst) : "memory"); }
constexpr float ATT_THR = 8.f;
#define ATT_WAITV(n) asm volatile("s_waitcnt vmcnt(" #n ") lgkmcnt(0)" ::: "memory")
template <int MODE>
__device__ __forceinline__ void attn_unit(LAS unsigned char* lds, const AUnit& U) {
    constexpr int DQK = (MODE == 0) ? 96 : 64, ND = DQK / 16, KSLOT = (DQK / 8) * 1024, VSLOT = 8192, NPW = (MODE == 0) ? 3 : 2;
    int tid = threadIdx.x; asm volatile("" : "+v"(tid));
    const int lane = tid & 63, w = __builtin_amdgcn_readfirstlane(tid >> 6), r32 = lane & 31, hh = lane >> 5;
    bf16x8 qf[ND];
    float m_ref = (MODE == 2) ? U.sink : 0.f, l = (MODE == 2 && hh == 0) ? 1.f : 0.f;
    bool first = (MODE != 2);
    f32x16 o0, o1, p0, p1, negm;
#pragma unroll
    for (int r = 0; r < 16; ++r) { o0[r] = 0.f; o1[r] = 0.f; p0[r] = 0.f; p1[r] = 0.f; negm[r] = -m_ref; }
    const int krow_ = 8 * w + (lane >> 3);
    const size_t koff = (size_t)krow_ * U.kpitch + (((lane & 7) ^ ((krow_ >> 1) & 7)) * 8);
    const size_t voff = (size_t)(16 * (w & 3) + (lane >> 2)) * U.kpitch + 32 * (w >> 2) + 8 * (lane & 3);
    const size_t roff1 = (size_t)lane * U.krpitch1 + (w & 3) * 8, roff2 = (size_t)lane * U.krpitch2 + (w & 3) * 8;
    const unsigned lds0 = (unsigned)(uintptr_t)lds;
#define ATT_DMA(t, slot) do { const bool s2_ = (t) >= U.t_split; const size_t kk_ = (size_t)(s2_ ? (t) - U.t_split : (t)) * 64; \
        glds16((s2_ ? U.k2 : U.k1) + kk_ * U.kpitch + koff, (unsigned)__builtin_amdgcn_readfirstlane(lds0 + LDS_K0 + (slot) * KSLOT + w * 1024)); \
        if (MODE == 0) glds16(s2_ ? U.kr2 + kk_ * U.krpitch2 + roff2 : U.kr1 + kk_ * U.krpitch1 + roff1, (unsigned)__builtin_amdgcn_readfirstlane(lds0 + LDS_K0 + (slot) * KSLOT + (8 + (w & 3)) * 1024)); \
        glds16((s2_ ? U.v2 : U.v1) + kk_ * U.kpitch + voff, (unsigned)__builtin_amdgcn_readfirstlane(lds0 + LDS_V0 + (slot) * VSLOT + w * 1024)); } while (0)
#define ACTIVE(j) (U.wactive && (j) >= U.wt_lo && (j) <= U.wt_hi)
#define ATT_WAIT_BAR(ahead) do { if ((ahead) >= 2) { if (NPW == 3) ATT_WAITV(6); else ATT_WAITV(4); } else if ((ahead) == 1) { if (NPW == 3) ATT_WAITV(3); else ATT_WAITV(2); } else ATT_WAITV(0); \
        __builtin_amdgcn_s_barrier(); asm volatile("" ::: "memory"); } while (0)
#define ATT_QKMAX(j, slot) do { \
        const LAS unsigned char* kq = lds + LDS_K0 + (slot) * KSLOT + r32 * 128; \
        _Pragma("unroll") for (int d0 = 0; d0 < ND; ++d0) { const int sw_ = (((2 * d0 + hh) ^ ((r32 >> 1) & 7)) & 7) * 16 + (d0 >= 4 ? 8192 : 0); \
            const bf16x8 ka = *(const LAS bf16x8*)(kq + sw_), kb2 = *(const LAS bf16x8*)(kq + 4096 + sw_); \
            p0 = __builtin_amdgcn_mfma_f32_32x32x16_bf16(ka, qf[d0], d0 == 0 ? negm : p0, 0, 0, 0); \
            p1 = __builtin_amdgcn_mfma_f32_32x32x16_bf16(kb2, qf[d0], d0 == 0 ? negm : p1, 0, 0, 0); } \
        if (MODE == 1) { const LAS float* bl = (const LAS float*)(lds + LDS_BIAS); \
            if (U.wchunk - (j) >= 3) { const float bc = bl[256]; _Pragma("unroll") for (int r = 0; r < 16; ++r) { p0[r] += bc; p1[r] += bc; } } \
            else { const int rel0 = U.qpos0 + r32 - 64 * (j) - 4 * hh; \
                _Pragma("unroll") for (int r = 0; r < 16; ++r) { const int rel = rel0 - ((r & 3) + 8 * (r >> 2)); \
                    p0[r] += bl[min(max(rel, -128), 128) + 128]; p1[r] += bl[min(max(rel - 32, -128), 128) + 128]; } } } \
        float rm = fmaxf(p0[0], p1[0]); \
        _Pragma("unroll") for (int r = 1; r < 16; ++r) rm = fmaxf(rm, fmaxf(p0[r], p1[r])); \
        rm = xhalf_max(rm); \
        if (first || __builtin_amdgcn_ballot_w64(rm > ATT_THR) != 0ull) { \
            const float dl = first ? rm : fmaxf(rm, 0.f); \
            m_ref += dl; \
            _Pragma("unroll") for (int r = 0; r < 16; ++r) { p0[r] -= dl; p1[r] -= dl; } \
            if (!first) { const float f = __builtin_amdgcn_exp2f(-dl); l *= f; \
                _Pragma("unroll") for (int r = 0; r < 16; ++r) { o0[r] *= f; o1[r] *= f; } } \
            _Pragma("unroll") for (int r = 0; r < 16; ++r) negm[r] = -m_ref; \
            first = false; } } while (0)
#define ATT_EXPPV(slot) do { \
        float ps = 0.f; \
        _Pragma("unroll") for (int r = 0; r < 16; ++r) { p0[r] = __builtin_amdgcn_exp2f(p0[r]); p1[r] = __builtin_amdgcn_exp2f(p1[r]); ps += p0[r] + p1[r]; } \
        l += ps; \
        u32x4 pw[4]; \
        pw[0] = (u32x4){pk2(p0[0], p0[1]), pk2(p0[2], p0[3]), pk2(p0[4], p0[5]), pk2(p0[6], p0[7])}; \
        pw[1] = (u32x4){pk2(p0[8], p0[9]), pk2(p0[10], p0[11]), pk2(p0[12], p0[13]), pk2(p0[14], p0[15])}; \
        pw[2] = (u32x4){pk2(p1[0], p1[1]), pk2(p1[2], p1[3]), pk2(p1[4], p1[5]), pk2(p1[6], p1[7])}; \
        pw[3] = (u32x4){pk2(p1[8], p1[9]), pk2(p1[10], p1[11]), pk2(p1[12], p1[13]), pk2(p1[14], p1[15])}; \
        const LAS char* vq = (const LAS char*)lds + LDS_V0 + (slot) * VSLOT + ((lane >> 4) & 1) * 32 + (lane & 3) * 8 + (4 * hh + ((lane & 15) >> 2)) * 64; \
        _Pragma("unroll") for (int kg = 0; kg < 4; ++kg) { \
            const bf16x8 pb = __builtin_bit_cast(bf16x8, pw[kg]); \
            const s16x4 a0 = vtr(vq + kg * 1024), a1 = vtr(vq + kg * 1024 + 512), b0 = vtr(vq + 4096 + kg * 1024), b1 = vtr(vq + 4096 + kg * 1024 + 512); \
            const bf16x8 vf0 = (bf16x8){a0[0], a0[1], a0[2], a0[3], a1[0], a1[1], a1[2], a1[3]}; \
            const bf16x8 vf1 = (bf16x8){b0[0], b0[1], b0[2], b0[3], b1[0], b1[1], b1[2], b1[3]}; \
            o0 = __builtin_amdgcn_mfma_f32_32x32x16_bf16(vf0, pb, o0, 0, 0, 0); \
            o1 = __builtin_amdgcn_mfma_f32_32x32x16_bf16(vf1, pb, o1, 0, 0, 0); } } while (0)
    const int t_lo = U.t_lo, t_hi = U.t_hi;
    ATT_DMA(t_lo, 0);
    if (t_lo + 1 <= t_hi) ATT_DMA(t_lo + 1, 1);
    if (t_lo + 2 <= t_hi) ATT_DMA(t_lo + 2, 2);
    if (MODE != 0 && U.wactive) {
        LAS unsigned char* qs = lds + LDS_OST + w * (32 * OSTP);
        u32x4 qv[4];
#pragma unroll
        for (int i = 0; i < 4; ++i) qv[i] = *(const GAS u32x4*)(U.q + (size_t)(i * 8 + (lane >> 3)) * U.qpitch + (lane & 7) * 8);
#pragma unroll
        for (int i = 0; i < 4; ++i) *(LAS u32x4*)(qs + (i * 8 + (lane >> 3)) * OSTP + (lane & 7) * 16) = qv[i];
        asm volatile("s_waitcnt lgkmcnt(0)" ::: "memory");
#pragma unroll
        for (int d0 = 0; d0 < ND; ++d0) { qf[d0] = *(const LAS bf16x8*)(qs + r32 * OSTP + (2 * d0 + hh) * 16); asm volatile("" : "+v"(qf[d0])); }
    } else {
#pragma unroll
    for (int d0 = 0; d0 < ND; ++d0) { qf[d0] = U.wactive ? *(const GAS bf16x8*)(U.q + (size_t)r32 * U.qpitch + d0 * 16 + hh * 8) : (bf16x8){0, 0, 0, 0, 0, 0, 0, 0};
        asm volatile("" : "+v"(qf[d0])); }
    }
    ATT_WAIT_BAR(min(t_lo + 2, t_hi) - t_lo);
    int slot = 0;
#pragma unroll 1
    for (int i = t_lo; i <= t_hi; ++i) {
        if (i + 3 <= t_hi) ATT_DMA(i + 3, (slot + 3) & 3);
        if (ACTIVE(i)) { ATT_QKMAX(i, slot); ATT_EXPPV(slot); }
        ATT_WAIT_BAR(min(i + 3, t_hi) - (i + 1));
        slot = (slot + 1) & 3;
    }
#undef ATT_DMA
#undef ACTIVE
#undef ATT_WAIT_BAR
#undef ATT_QKMAX
#undef ATT_EXPPV
    if (U.wactive && !U.nostore) {
        l = xhalf_sum(l);
        const float inv = 1.0f / l;
        LAS unsigned char* stg = lds + LDS_OST + w * (32 * OSTP);
#pragma unroll
        for (int rg = 0; rg < 4; ++rg) {
            *(LAS u32x2*)(stg + r32 * OSTP + (8 * rg + 4 * hh) * 2) = (u32x2){pk2(o0[4 * rg] * inv, o0[4 * rg + 1] * inv), pk2(o0[4 * rg + 2] * inv, o0[4 * rg + 3] * inv)};
            *(LAS u32x2*)(stg + r32 * OSTP + (32 + 8 * rg + 4 * hh) * 2) = (u32x2){pk2(o1[4 * rg] * inv, o1[4 * rg + 1] * inv), pk2(o1[4 * rg + 2] * inv, o1[4 * rg + 3] * inv)};
        }
        asm volatile("s_waitcnt lgkmcnt(0)" ::: "memory");
#pragma unroll
        for (int i = 0; i < 4; ++i) {
            const int row = i * 8 + (lane >> 3), ch = lane & 7;
            const u32x4 ov = *(const LAS u32x4*)(stg + row * OSTP + ch * 16);
            const u32x4 gv = *(const GAS u32x4*)(U.g + (size_t)row * U.opitch + ch * 8);
            u32x4 r;
            r.x = pk2(bflo(ov.x) * bflo(gv.x), bfhi(ov.x) * bfhi(gv.x)); r.y = pk2(bflo(ov.y) * bflo(gv.y), bfhi(ov.y) * bfhi(gv.y));
            r.z = pk2(bflo(ov.z) * bflo(gv.z), bfhi(ov.z) * bfhi(gv.z)); r.w = pk2(bflo(ov.w) * bflo(gv.w), bfhi(ov.w) * bfhi(gv.w));
            *(GAS u32x4*)(U.o + (size_t)row * U.opitch + ch * 8) = r;
        }
    }
}
__device__ __forceinline__ void attn_unit_mla(LAS unsigned char* lds, const AUnit& U) {
    constexpr int ND = 6, KSLOT = 12288, VSLOT = 8192;
    int tid = threadIdx.x; asm volatile("" : "+v"(tid));
    const int lane = tid & 63, w = __builtin_amdgcn_readfirstlane(tid >> 6), r32 = lane & 31, hh = lane >> 5;
    const int rg = w & 3, kh = w >> 2;
    bf16x8 qf[2][ND];
    float m_ref[2] = {0.f, 0.f}, l[2] = {0.f, 0.f};
    bool first = true;
    f32x16 o[2][2];
#pragma unroll
    for (int r = 0; r < 16; ++r) { o[0][0][r] = 0.f; o[0][1][r] = 0.f; o[1][0][r] = 0.f; o[1][1][r] = 0.f; }
    const int krow_ = 8 * w + (lane >> 3), rrow_ = 16 * (w & 3) + (lane >> 2);
    const size_t koff = (size_t)krow_ * U.kpitch + (((lane & 7) ^ ((krow_ >> 1) & 7)) * 8);
    const size_t voff = (size_t)(16 * (w & 3) + (lane >> 2)) * U.kpitch + 32 * (w >> 2) + 8 * (lane & 3);
    const int rsw_ = ((lane & 3) ^ ((rrow_ >> 2) & 3)) * 8;
    const size_t roff1 = (size_t)rrow_ * U.krpitch1 + rsw_, roff2 = (size_t)rrow_ * U.krpitch2 + rsw_;
    const unsigned lds0 = (unsigned)(uintptr_t)lds;
#define MLA_DMA(t, slot) do { const bool s2_ = (t) >= U.t_split; const size_t kk_ = (size_t)(s2_ ? (t) - U.t_split : (t)) * 64; \
        glds16((s2_ ? U.k2 : U.k1) + kk_ * U.kpitch + koff, (unsigned)__builtin_amdgcn_readfirstlane(lds0 + LDS_K0 + (slot) * KSLOT + w * 1024)); \
        glds16(s2_ ? U.kr2 + kk_ * U.krpitch2 + roff2 : U.kr1 + kk_ * U.krpitch1 + roff1, (unsigned)__builtin_amdgcn_readfirstlane(lds0 + LDS_K0 + (slot) * KSLOT + (8 + (w & 3)) * 1024)); \
        glds16((s2_ ? U.v2 : U.v1) + kk_ * U.kpitch + voff, (unsigned)__builtin_amdgcn_readfirstlane(lds0 + LDS_V0 + (slot) * VSLOT + w * 1024)); } while (0)
#define MLA_WAIT_BAR(ahead) do { if ((ahead) >= 2) ATT_WAITV(6); else if ((ahead) == 1) ATT_WAITV(3); else ATT_WAITV(0); __builtin_amdgcn_s_barrier(); asm volatile("" ::: "memory"); } while (0)
    const int t_lo = U.t_lo, t_hi = U.t_hi;
    MLA_DMA(t_lo, 0);
    if (t_lo + 1 <= t_hi) MLA_DMA(t_lo + 1, 1);
    if (t_lo + 2 <= t_hi) MLA_DMA(t_lo + 2, 2);
    if (U.wactive) {
        LAS unsigned char* qs = lds + LDS_OST + w * 6144;
#pragma unroll
        for (int rb = 0; rb < 2; ++rb) {
            u32x4 qv[6];
#pragma unroll
            for (int i = 0; i < 6; ++i) { const int e = i * 64 + lane, row = e / 12, ch = e % 12; qv[i] = *(const GAS u32x4*)(U.q + (size_t)(32 * rb + row) * U.qpitch + ch * 8); }
#pragma unroll
            for (int i = 0; i < 6; ++i) { const int e = i * 64 + lane; *(LAS u32x4*)(qs + e * 16) = qv[i]; }
            asm volatile("s_waitcnt lgkmcnt(0)" ::: "memory");
#pragma unroll
            for (int d0 = 0; d0 < ND; ++d0) { qf[rb][d0] = *(const LAS bf16x8*)(qs + r32 * 192 + (2 * d0 + hh) * 16); asm volatile("" : "+v"(qf[rb][d0])); }
            asm volatile("s_waitcnt lgkmcnt(0)" ::: "memory");
        }
    } else {
#pragma unroll
        for (int rb = 0; rb < 2; ++rb)
#pragma unroll
            for (int d0 = 0; d0 < ND; ++d0) qf[rb][d0] = (bf16x8){0, 0, 0, 0, 0, 0, 0, 0};
    }
    MLA_WAIT_BAR(min(t_lo + 2, t_hi) - t_lo);
    int slot = 0;
#pragma unroll 1
    for (int i = t_lo; i <= t_hi; ++i) {
        if (i + 3 <= t_hi) MLA_DMA(i + 3, (slot + 3) & 3);
        if (U.wactive && i >= U.wt_lo && i <= U.wt_hi) {
            f32x16 p[2];
            const LAS unsigned char* kq = lds + LDS_K0 + slot * KSLOT;
            const int krd_ = r32 + 32 * kh;
#pragma unroll
            for (int d0 = 0; d0 < ND; ++d0) {
                const int ko_ = d0 < 4 ? krd_ * 128 + ((((2 * d0 + hh) ^ ((r32 >> 1) & 7)) & 7) * 16) : 8192 + krd_ * 64 + ((((2 * (d0 - 4) + hh) ^ ((r32 >> 2) & 3)) & 3) * 16);
                const bf16x8 kf = *(const LAS bf16x8*)(kq + ko_);
                if (d0 == 0) { f32x16 z;
#pragma unroll
                    for (int r = 0; r < 16; ++r) z[r] = 0.f;
                    p[0] = __builtin_amdgcn_mfma_f32_32x32x16_bf16(kf, qf[0][0], z, 0, 0, 0); p[1] = __builtin_amdgcn_mfma_f32_32x32x16_bf16(kf, qf[1][0], z, 0, 0, 0);
                } else { p[0] = __builtin_amdgcn_mfma_f32_32x32x16_bf16(kf, qf[0][d0], p[0], 0, 0, 0); p[1] = __builtin_amdgcn_mfma_f32_32x32x16_bf16(kf, qf[1][d0], p[1], 0, 0, 0); }
            }
            float rm[2];
#pragma unroll
            for (int rb = 0; rb < 2; ++rb) { float x = p[rb][0];
#pragma unroll
                for (int r = 1; r < 16; ++r) x = fmaxf(x, p[rb][r]);
                rm[rb] = xhalf_max(x); }
            if (first || __builtin_amdgcn_ballot_w64(rm[0] - m_ref[0] > ATT_THR || rm[1] - m_ref[1] > ATT_THR) != 0ull) {
#pragma unroll
                for (int rb = 0; rb < 2; ++rb) { const float mn = first ? rm[rb] : fmaxf(m_ref[rb], rm[rb]);
                    if (!first) { const float f = __builtin_amdgcn_exp2f(m_ref[rb] - mn); l[rb] *= f;
#pragma unroll
                        for (int r = 0; r < 16; ++r) { o[rb][0][r] *= f; o[rb][1][r] *= f; } }
                    m_ref[rb] = mn; }
                first = false;
            }
            u32x4 pw[2][2];
#pragma unroll
            for (int rb = 0; rb < 2; ++rb) { float ps = 0.f;
#pragma unroll
                for (int r = 0; r < 16; ++r) { p[rb][r] = __builtin_amdgcn_exp2f(p[rb][r] - m_ref[rb]); ps += p[rb][r]; }
                l[rb] += ps;
                pw[rb][0] = (u32x4){pk2(p[rb][0], p[rb][1]), pk2(p[rb][2], p[rb][3]), pk2(p[rb][4], p[rb][5]), pk2(p[rb][6], p[rb][7])};
                pw[rb][1] = (u32x4){pk2(p[rb][8], p[rb][9]), pk2(p[rb][10], p[rb][11]), pk2(p[rb][12], p[rb][13]), pk2(p[rb][14], p[rb][15])}; }
            const LAS char* vq = (const LAS char*)lds + LDS_V0 + slot * VSLOT + ((lane >> 4) & 1) * 32 + (lane & 3) * 8 + (4 * hh + ((lane & 15) >> 2)) * 64 + kh * 2048;
#pragma unroll
            for (int ks = 0; ks < 2; ++ks) {
                const s16x4 a0 = vtr(vq + ks * 1024), a1 = vtr(vq + ks * 1024 + 512), b0 = vtr(vq + 4096 + ks * 1024), b1 = vtr(vq + 4096 + ks * 1024 + 512);
                const bf16x8 vf0 = (bf16x8){a0[0], a0[1], a0[2], a0[3], a1[0], a1[1], a1[2], a1[3]};
                const bf16x8 vf1 = (bf16x8){b0[0], b0[1], b0[2], b0[3], b1[0], b1[1], b1[2], b1[3]};
#pragma unroll
                for (int rb = 0; rb < 2; ++rb) { const bf16x8 pb = __builtin_bit_cast(bf16x8, pw[rb][ks]);
                    o[rb][0] = __builtin_amdgcn_mfma_f32_32x32x16_bf16(vf0, pb, o[rb][0], 0, 0, 0);
                    o[rb][1] = __builtin_amdgcn_mfma_f32_32x32x16_bf16(vf1, pb, o[rb][1], 0, 0, 0); }
            }
        }
        MLA_WAIT_BAR(min(i + 3, t_hi) - (i + 1));
        slot = (slot + 1) & 3;
    }
#undef MLA_DMA
#undef MLA_WAIT_BAR
    LAS float* X = (LAS float*)(lds + rg * 17408) + lane;
    if (U.wactive && kh == 1) {
#pragma unroll
        for (int rb = 0; rb < 2; ++rb) { X[(0 + rb) * 64] = first ? -1e30f : m_ref[rb]; X[(2 + rb) * 64] = xhalf_sum(l[rb]);
#pragma unroll
            for (int dh = 0; dh < 2; ++dh)
#pragma unroll
                for (int r = 0; r < 16; ++r) X[(4 + rb * 32 + dh * 16 + r) * 64] = o[rb][dh][r]; }
    }
    asm volatile("s_waitcnt lgkmcnt(0)" ::: "memory"); __builtin_amdgcn_s_barrier(); asm volatile("" ::: "memory");
    if (U.wactive && kh == 0) {
        LAS unsigned char* stg = lds + LDS_OST + rg * (64 * OSTP);
#pragma unroll
        for (int rb = 0; rb < 2; ++rb) {
            const float m0 = first ? -1e30f : m_ref[rb], m1 = X[(0 + rb) * 64], l0 = xhalf_sum(l[rb]), l1 = X[(2 + rb) * 64];
            const float mm = fmaxf(m0, m1), f0 = __builtin_amdgcn_exp2f(m0 - mm), f1 = __builtin_amdgcn_exp2f(m1 - mm);
            const float inv = 1.0f / (l0 * f0 + l1 * f1), c0 = f0 * inv, c1 = f1 * inv;
#pragma unroll
            for (int dh = 0; dh < 2; ++dh)
#pragma unroll
                for (int rq = 0; rq < 4; ++rq) {
                    float v[4];
#pragma unroll
                    for (int e = 0; e < 4; ++e) v[e] = o[rb][dh][4 * rq + e] * c0 + X[(4 + rb * 32 + dh * 16 + 4 * rq + e) * 64] * c1;
                    *(LAS u32x2*)(stg + (32 * rb + r32) * OSTP + (32 * dh + 8 * rq + 4 * hh) * 2) = (u32x2){pk2(v[0], v[1]), pk2(v[2], v[3])};
                }
        }
        asm volatile("s_waitcnt lgkmcnt(0)" ::: "memory");
#pragma unroll
        for (int i = 0; i < 8; ++i) {
            const int row = i * 8 + (lane >> 3), ch = lane & 7;
            const u32x4 ov = *(const LAS u32x4*)(stg + row * OSTP + ch * 16);
            const u32x4 gv = *(const GAS u32x4*)(U.g + (size_t)row * U.opitch + ch * 8);
            u32x4 r;
            r.x = pk2(bflo(ov.x) * bflo(gv.x), bfhi(ov.x) * bfhi(gv.x)); r.y = pk2(bflo(ov.y) * bflo(gv.y), bfhi(ov.y) * bfhi(gv.y));
            r.z = pk2(bflo(ov.z) * bflo(gv.z), bfhi(ov.z) * bfhi(gv.z)); r.w = pk2(bflo(ov.w) * bflo(gv.w), bfhi(ov.w) * bfhi(gv.w));
            *(GAS u32x4*)(U.o + (size_t)row * U.opitch + ch * 8) = r;
        }
    }
    asm volatile("s_waitcnt lgkmcnt(0)" ::: "memory"); __builtin_amdgcn_s_barrier(); asm volatile("" ::: "memory");
}
__device__ __forceinline__ unsigned unit_ask(GAS unsigned* ctr) { return threadIdx.x == 0 ? __hip_atomic_fetch_add(ctr, 1u, __ATOMIC_RELAXED, __HIP_MEMORY_SCOPE_AGENT) : 0u; }
__device__ __forceinline__ int unit_take(LAS unsigned char* lds, unsigned asked) {
    volatile LAS int* sw = (volatile LAS int*)(lds + LDS_SCHED);
    __syncthreads();
    if (threadIdx.x == 0) *sw = (int)asked;
    __syncthreads();
    return __builtin_amdgcn_readfirstlane(*sw);
}
}


#define XB_TMO      128
#define XB_XCNT(j)  (256  + 64 * (j))
#define XB_XSUB(j)  (1280 + 64 * (j))
#define XB_XGEN(j)  (2304 + 64 * (j))
#define XB_TOP      3328
#define XB_TOPGEN   3392
#define XCD_BAR_WORDS 3456
#define XB_SPIN_CAP (1u << 22)
__device__ __forceinline__ unsigned xb_ld(unsigned* p)              { return __hip_atomic_load(p, __ATOMIC_RELAXED, __HIP_MEMORY_SCOPE_AGENT); }
__device__ __forceinline__ unsigned xb_add(unsigned* p, unsigned v) { return __hip_atomic_fetch_add(p, v, __ATOMIC_RELAXED, __HIP_MEMORY_SCOPE_AGENT); }
__device__ __forceinline__ unsigned xb_xcc_id() { return (unsigned)__builtin_amdgcn_s_getreg((3 << 11) | 20) & 0xFu; }
#define XB_SPIN(cond, bar) do { unsigned _sp = 0; while (cond) { __builtin_amdgcn_s_sleep(1); \
    if ((++_sp & 255u) == 0u) { if (xb_ld(&(bar)[XB_TMO])) break; if (_sp > XB_SPIN_CAP) { atomicAdd(&(bar)[XB_TMO], 1u); break; } } } } while (0)
struct XcdBarrier { unsigned* bar; unsigned x; volatile LAS unsigned* st; };
__device__ __forceinline__ XcdBarrier xcd_barrier_post(unsigned* bar, volatile LAS unsigned* st) {
    XcdBarrier b; b.bar = bar; b.x = xb_xcc_id(); b.st = st;
    if (threadIdx.x == 0) (void)xb_add(&bar[XB_XCNT(b.x)], 1u);
    return b;
}
__device__ __forceinline__ void xcd_barrier_complete(unsigned* bar, unsigned x, unsigned& nloc, unsigned& nx) {
    const unsigned G = gridDim.x * gridDim.y * gridDim.z;
    unsigned sum, cnt, mine, sp = 0u;
    for (;;) {
        sum = 0u; cnt = 0u; mine = 0u;
#pragma unroll
        for (unsigned j = 0; j < 16; ++j) { const unsigned c = xb_ld(&bar[XB_XCNT(j)]); sum += c; cnt += (c > 0u) ? 1u : 0u; mine = (j == x) ? c : mine; }
        if (sum == G) break;
        __builtin_amdgcn_s_sleep(1);
        if ((++sp & 255u) == 0u) { if (xb_ld(&bar[XB_TMO])) break; if (sp > XB_SPIN_CAP) { atomicAdd(&bar[XB_TMO], 1u); break; } }
    }
    nloc = mine > 0u ? mine : 1u; nx = cnt > 0u ? cnt : 1u;
}
__device__ __forceinline__ void xcd_barrier(const XcdBarrier& b) {
    asm volatile("s_waitcnt vmcnt(0)" ::: "memory");
    __syncthreads();
    if (threadIdx.x == 0) {
        unsigned* bar = b.bar;
        __builtin_amdgcn_s_waitcnt(0);
        unsigned nloc = b.st[0], nx = b.st[1];
        if (nloc == 0u) { xcd_barrier_complete(bar, b.x, nloc, nx); b.st[0] = nloc; b.st[1] = nx; }
        const unsigned old = xb_add(&bar[XB_XSUB(b.x)], 1u);
        const unsigned gen = old / nloc;
        if (old + 1u == (gen + 1u) * nloc) {
            __builtin_amdgcn_fence(__ATOMIC_RELEASE, "agent");
            asm volatile("s_waitcnt vmcnt(0)" ::: "memory");
            const unsigned og = xb_add(&bar[XB_TOP], 1u);
            const unsigned tg = og / nx;
            if (og + 1u == (tg + 1u) * nx) xb_add(&bar[XB_TOPGEN], 1u);
            else XB_SPIN(xb_ld(&bar[XB_TOPGEN]) == tg, bar);
            __builtin_amdgcn_fence(__ATOMIC_ACQUIRE, "agent");
            xb_add(&bar[XB_XGEN(b.x)], 1u);
            asm volatile("s_waitcnt vmcnt(0)" ::: "memory");
        } else {
            XB_SPIN(xb_ld(&bar[XB_XGEN(b.x)]) == gen, bar);
            __builtin_amdgcn_fence(__ATOMIC_ACQUIRE, "agent");
            asm volatile("s_waitcnt vmcnt(0)" ::: "memory");
        }
    }
    __syncthreads();
}

struct Args { const float* in[22]; float* out; unsigned char* ws; int ph_lo, ph_hi; };
enum { I_XP = 0, I_XS, I_CA_CKV, I_CA_KR, I_CB_K, I_CB_V, I_CC_K, I_CC_V, I_AB_PRE, I_AB_POST, I_AB_WIN, I_AB_QN, I_AB_KVN, I_AB_WUQ, I_AB_WUKV, I_AB_REL, I_AB_WOUT,
       I_C_PRE, I_C_POST, I_C_WIN, I_C_SINKS, I_C_WOUT };

__device__ __forceinline__ void transpose_item(const GAS float* W, int K, int N, GAS bf16_t* WT, LAS float* scr, int item, int lane, int shift_nb = 1 << 30) {
    const int nblk = N / 32, kb = item / nblk, nb = item % nblk, k0 = 64 * kb, n0 = 32 * nb, rsh = nb >= shift_nb ? 32 : 0;
#pragma unroll 8
    for (int i = 0; i < 32; ++i) { const int kk = 2 * i + (lane >> 5); scr[kk * 33 + (lane & 31)] = __builtin_nontemporal_load(W + (size_t)(k0 + kk) * N + n0 + (lane & 31)); }
    asm volatile("s_waitcnt lgkmcnt(0)" ::: "memory");
    const int c = lane & 7;
#pragma unroll
    for (int j = 0; j < 4; ++j) { const int n = (lane >> 3) + 8 * j; const LAS float* s = scr + (8 * c) * 33 + n;
        u32x4 o; o.x = pk2(s[0 * 33], s[1 * 33]); o.y = pk2(s[2 * 33], s[3 * 33]); o.z = pk2(s[4 * 33], s[5 * 33]); o.w = pk2(s[6 * 33], s[7 * 33]);
        *(GAS u32x4*)(WT + (size_t)(rsh + n0 + n) * K + k0 + 8 * c) = o; }
    asm volatile("s_waitcnt lgkmcnt(0)" ::: "memory");
}
__device__ __forceinline__ void rms_row_to_bf16(const GAS float* xrow, const GAS float* gain, GAS bf16_t* orow, int lane) {
    const GAS f32x4* xr = (const GAS f32x4*)xrow + lane; const GAS f32x4* gr = (const GAS f32x4*)gain + lane;
    f32x4 v[4]; float s = 0.f;
#pragma unroll
    for (int j = 0; j < 4; ++j) { v[j] = xr[64 * j]; s += (v[j].x * v[j].x + v[j].y * v[j].y) + (v[j].z * v[j].z + v[j].w * v[j].w); }
    const float rstd = 1.0f / sqrtf(wave_sum(s) * (1.f / DM) + RMS_EPS);
    GAS u32x2* o8 = (GAS u32x2*)orow + lane;
#pragma unroll
    for (int j = 0; j < 4; ++j) { const f32x4 g = gr[64 * j]; u32x2 w; w.x = pk2(v[j].x * rstd * g.x, v[j].y * rstd * g.y); w.y = pk2(v[j].z * rstd * g.z, v[j].w * rstd * g.w); o8[64 * j] = w; }
}

__global__ void __launch_bounds__(512, 2) mega_fwd(Args a) {
    extern __shared__ __attribute__((aligned(16))) unsigned char lds_raw[];
    LAS unsigned char* lds = (LAS unsigned char*)lds_raw;
    cg::grid_group grid = cg::this_grid();
#define GIN(k) ((const GAS float*)a.in[k])
    const int G = gridDim.x, bx = blockIdx.x;
    constexpr int LDS_XB = 132 * 1024;
    if (threadIdx.x < 2) ((volatile LAS unsigned*)(lds + LDS_XB))[threadIdx.x] = 0u;
    __syncthreads();
    const XcdBarrier xbar = xcd_barrier_post((unsigned*)(a.ws + WS_CTL) + 1024, (volatile LAS unsigned*)(lds + LDS_XB));
#define PHASE_PTRS \
    int tid = threadIdx.x; asm volatile("" : "+v"(tid)); const int lane = tid & 63, wave = __builtin_amdgcn_readfirstlane(tid >> 6); (void)lane;   \
    const int gw = bx * 8 + wave, NGW = G * 8; (void)gw; (void)NGW; \
    const size_t gt = (size_t)bx * 512 + tid, NGT = (size_t)G * 512; (void)gt; (void)NGT; \
    GAS unsigned char* ws = (GAS unsigned char*)a.ws; GAS float* dout = (GAS float*)a.out; asm volatile("" : "+s"(ws), "+s"(dout));   \
    GAS unsigned* ctl = (GAS unsigned*)(ws + WS_CTL); (void)ctl; \
    GAS f32x2* ropeA = (GAS f32x2*)(ws + WS_ROPEA); GAS f32x2* ropeC = (GAS f32x2*)(ws + WS_ROPEC); (void)ropeA; (void)ropeC; \
    GAS bf16_t* WIN0 = (GAS bf16_t*)(ws + WS_WIN0); GAS bf16_t* WUQ = (GAS bf16_t*)(ws + WS_WUQ); GAS bf16_t* WUKV = (GAS bf16_t*)(ws + WS_WUKV); (void)WIN0; (void)WUQ; (void)WUKV; \
    GAS bf16_t* WOUT0 = (GAS bf16_t*)(ws + WS_WOUT0); GAS bf16_t* WIN1 = (GAS bf16_t*)(ws + WS_WIN1); GAS bf16_t* WOUT1 = (GAS bf16_t*)(ws + WS_WOUT1); (void)WOUT0; (void)WIN1; (void)WOUT1; \
    GAS bf16_t* KCS = (GAS bf16_t*)(ws + WS_KCS); GAS bf16_t* VCS = (GAS bf16_t*)(ws + WS_VCS); (void)KCS; (void)VCS; \
    GAS bf16_t* Z = (GAS bf16_t*)(ws + WS_Z); GAS bf16_t* KVB = (GAS bf16_t*)(ws + WS_KVB); GAS bf16_t* CACHEC = (GAS bf16_t*)(ws + WS_CACHEC); GAS bf16_t* KRC = (GAS bf16_t*)(ws + WS_KRC); (void)Z; (void)KVB; (void)CACHEC; (void)KRC; \
    GAS bf16_t* KBS = (GAS bf16_t*)(ws + WS_KBS); GAS bf16_t* VBS = (GAS bf16_t*)(ws + WS_VBS); (void)KBS; (void)VBS; \
    GAS bf16_t* Y = (GAS bf16_t*)(ws + WS_Y); GAS bf16_t* H1 = (GAS bf16_t*)(ws + WS_H1); (void)H1; GAS float* YP = (GAS float*)(ws + WS_YP); (void)YP; GAS bf16_t* XN1 = (GAS bf16_t*)(ws + WS_XN1); (void)Y; (void)XN1; \
    GAS bf16_t* XN0 = (GAS bf16_t*)((GAS unsigned char*)dout + DO_XN0); GAS bf16_t* QA = (GAS bf16_t*)((GAS unsigned char*)dout + DO_QA); (void)XN0; (void)QA;
    const int lo = a.ph_lo, hi = a.ph_hi;
    if (lo < 0) grid.sync();
#ifdef PROBE_G2
#define PROBE_GEMM_REP for (int rep_ = 0; rep_ < (a.ph_hi > 5 ? 2 : 1); ++rep_)
#else
#define PROBE_GEMM_REP
#endif
#ifdef PROBE_SYNC
#define EXTRA_SYNC() do { if (a.ph_hi > 5) xcd_barrier(xbar); } while (0)
#else
#define EXTRA_SYNC() do {} while (0)
#endif
#define IN(k) (lo <= (k) && (k) < hi)
#define SEAM(k) do { if (IN(k) && IN((k) + 1)) { xcd_barrier(xbar); EXTRA_SYNC(); } } while (0)

    if (IN(0)) {
        PHASE_PTRS
        LAS float* scr = (LAS float*)(lds + wave * 16384);
        constexpr int I0 = 16 * 101, I1 = 6 * 24, I2 = 4 * 32, I3 = 16 * 32, I4 = 16 * 72, I5 = 16 * 32;
        for (int it = gw; it < I0 + I1 + I2 + I3; it += NGW) {
            int r = it;
            if (r < I0) { transpose_item(GIN(I_AB_WIN), 1024, 3232, WIN0, scr, r, lane, 21); continue; } r -= I0;
            if (r < I1) { transpose_item(GIN(I_AB_WUQ), 384, 768, WUQ, scr, r, lane); continue; } r -= I1;
            if (r < I2) { transpose_item(GIN(I_AB_WUKV), 256, 1024, WUKV, scr, r, lane); continue; } r -= I2;
            transpose_item(GIN(I_AB_WOUT), 1024, 1024, WOUT0, scr, r, lane);
        }
        for (size_t i = gt; i < (size_t)96 * 1024 / 8; i += NGT) { const size_t rr = i >> 7; ((GAS u32x4*)(WIN0 + (size_t)(rr < 32 ? 672 + rr : 3264 + (rr - 32)) * 1024))[i & 127] = (u32x4){0u, 0u, 0u, 0u}; }
        for (size_t i = gt; i < (size_t)8192 * 16; i += NGT) {
            const int pos = (int)(i >> 4), j = (int)(i & 15);
            const float inv = exp2f(-(float)j * 1.18322304f);
            const float ang = (float)pos * inv;
            const f32x2 cs = {cosf(ang), sinf(ang)};
            ropeA[i] = cs; if ((j & 1) == 0) ropeC[(size_t)pos * 8 + (j >> 1)] = cs;
        }
        {
            f32x4 nx[4];
#define P0_LOAD(r) do { const GAS f32x4* xr_ = (const GAS f32x4*)((r) < MP ? GIN(I_XP) + (size_t)(r) * DM : GIN(I_XS) + (size_t)((r) - MP) * DM) + lane; \
                _Pragma("unroll") for (int j = 0; j < 4; ++j) nx[j] = __builtin_nontemporal_load(xr_ + 64 * j); } while (0)
            const GAS f32x4* gr = (const GAS f32x4*)GIN(I_AB_PRE) + lane;
            if (gw < MT) P0_LOAD(gw);
            for (int r = gw; r < MT; r += NGW) {
                f32x4 v[4]; float sq = 0.f;
#pragma unroll
                for (int j = 0; j < 4; ++j) { v[j] = nx[j]; sq += (v[j].x * v[j].x + v[j].y * v[j].y) + (v[j].z * v[j].z + v[j].w * v[j].w); }
                if (r + NGW < MT) P0_LOAD(r + NGW);
                const float rstd = 1.0f / sqrtf(wave_sum(sq) * (1.f / DM) + RMS_EPS);
                GAS u32x2* o8 = (GAS u32x2*)(XN0 + (size_t)r * DM) + lane;
#pragma unroll
                for (int j = 0; j < 4; ++j) { const f32x4 g = gr[64 * j]; o8[64 * j] = (u32x2){pk2(v[j].x * rstd * g.x, v[j].y * rstd * g.y), pk2(v[j].z * rstd * g.z, v[j].w * rstd * g.w)}; }
            }
#undef P0_LOAD
        }
        for (size_t i = gt; i < (size_t)8 * 4096 * 256 / 4; i += NGT) { const f32x4 v = __builtin_nontemporal_load((const GAS f32x4*)GIN(I_CA_CKV) + i); ((GAS u32x2*)CACHEC)[i] = (u32x2){pk2(v.x, v.y), pk2(v.z, v.w)}; }
    }
    SEAM(0);

    if (IN(1)) {
        PHASE_PTRS
        pg8::Gemm g{XN0, WIN0, MT, ZP, 1024, 1024, 1024}; pg8::StaticOrder S; S.init(MT, ZP, G, bx);
        pg8::EpiStrip<0> E{Z, ZP, (const GAS f32x4*)ropeA, (const GAS f32x4*)ropeC, dout, KCS, VCS};
        PROBE_GEMM_REP pg8::gemm_phase<pg8::EpiStrip<0>, true>(lds, g, S, E);
        const int nlate = 858 - 3 * G;
        if (nlate > 0 && nlate < G) {
            pg8::Gemm g2{CACHEC, WUKV, 32768, 1024, 256, 256, 256}; pg8::StaticOrder S2; S2.init(32768, 1024, G - nlate, bx - nlate);
            if (bx < nlate) S2.init_one(-2, 0);
            pg8::EpiStrip<2> E2{KVB + (size_t)MT * 1024, 1024, (const GAS f32x4*)ropeA, (const GAS f32x4*)ropeC, dout, KCS, VCS};
            pg8::gemm_phase<pg8::EpiStrip<2>, true>(lds, g2, S2, E2);
        }
    }
    SEAM(1);

    if (IN(2)) {
        PHASE_PTRS
        for (size_t i = gt; i < (size_t)8 * 4096 * 32 / 4; i += NGT) { const f32x4 v = __builtin_nontemporal_load((const GAS f32x4*)GIN(I_CA_KR) + i); ((GAS u32x2*)KRC)[i] = (u32x2){pk2(v.x, v.y), pk2(v.z, v.w)}; }
        for (size_t i = gt; i < (size_t)2 * 8 * 512 * 512 / 4; i += NGT) {
            const int which = (int)(i / (8 * 512 * 512 / 4)); const size_t e = (i % (8 * 512 * 512 / 4)) * 4; const int b = (int)(e >> 18), t = (int)((e >> 9) & 511), c = (int)(e & 511);
            const f32x4 v = __builtin_nontemporal_load((const GAS f32x4*)((const GAS float*)a.in[which ? I_CB_V : I_CB_K] + e));
            *(GAS u32x2*)((which ? VBS : KBS) + ((size_t)b * 576 + t) * 512 + c) = (u32x2){pk2(v.x, v.y), pk2(v.z, v.w)};
            if (t >= 64) __builtin_nontemporal_store(v, (GAS f32x4*)(dout + (which ? O_BV_S : O_BK_S) + ((size_t)b * 512 + t - 64) * 512 + c));
        }
        for (size_t i = gt; i < (size_t)2 * 8 * 128 * 128 / 4; i += NGT) {
            const int which = (int)(i / (8 * 128 * 128 / 4)); const size_t e = (i % (8 * 128 * 128 / 4)) * 4; const int b = (int)(e >> 14), t = (int)((e >> 7) & 127), c = (int)(e & 127);
            const f32x4 v = __builtin_nontemporal_load((const GAS f32x4*)((const GAS float*)a.in[which ? I_CC_V : I_CC_K] + e));
            *(GAS u32x2*)((which ? VCS : KCS) + ((size_t)b * 192 + t) * 128 + c) = (u32x2){pk2(v.x, v.y), pk2(v.z, v.w)};
            if (t >= 64) __builtin_nontemporal_store(v, (GAS f32x4*)(dout + (which ? O_CV_S : O_CK_S) + ((size_t)b * 128 + t - 64) * 128 + c));
        }
        unsigned nq[3]; u32x2 nc; unsigned nk;
#define P2_LOAD(r) do { const GAS bf16_t* z_ = Z + (size_t)(r) * ZP; _Pragma("unroll") for (int j = 0; j < 3; ++j) nq[j] = *(const GAS unsigned*)(z_ + 2 * lane + 128 * j); \
            nc = *(const GAS u32x2*)(z_ + ZC_CKV + 4 * lane); nk = *(const GAS unsigned*)(z_ + ZC_KR + 2 * (lane & 15)); } while (0)
        if (gw < MT) P2_LOAD(gw);
        for (int r = gw; r < MT; r += NGW) {
            GAS bf16_t* zr = Z + (size_t)r * ZP;
            const bool smp = r >= MP; const int b = smp ? (r - MP) >> 6 : r >> 13, t = smp ? (r - MP) & 63 : r & 8191;
            unsigned wv[3]; const u32x2 wc2 = nc; const unsigned wk = nk;
#pragma unroll
            for (int j = 0; j < 3; ++j) wv[j] = nq[j];
            if (r + NGW < MT) P2_LOAD(r + NGW);
            {
                float s = 0.f;
#pragma unroll
                for (int j = 0; j < 3; ++j) { const float x0 = bflo(wv[j]), x1 = bfhi(wv[j]); s += x0 * x0 + x1 * x1; }
                const float rstd = 1.0f / sqrtf(wave_sum(s) * (1.f / 384.f) + RMS_EPS);
#pragma unroll
                for (int j = 0; j < 3; ++j) { const f32x2 gq = *(const GAS f32x2*)(GIN(I_AB_QN) + 2 * lane + 128 * j);
                    *(GAS unsigned*)(zr + 2 * lane + 128 * j) = pk2(bflo(wv[j]) * rstd * gq.x, bfhi(wv[j]) * rstd * gq.y); }
            }
            {
                const u32x2 wv2 = wc2;
                const float x0 = bflo(wv2.x), x1 = bfhi(wv2.x), x2 = bflo(wv2.y), x3 = bfhi(wv2.y);
                const float rstd = 1.0f / sqrtf(wave_sum(x0 * x0 + x1 * x1 + x2 * x2 + x3 * x3) * (1.f / 256.f) + RMS_EPS);
                const f32x4 gk = *(const GAS f32x4*)(GIN(I_AB_KVN) + 4 * lane);
                const f32x4 c = {x0 * rstd * gk.x, x1 * rstd * gk.y, x2 * rstd * gk.z, x3 * rstd * gk.w};
                *(GAS u32x2*)(zr + ZC_CKV + 4 * lane) = (u32x2){pk2(c.x, c.y), pk2(c.z, c.w)};
                __builtin_nontemporal_store(c, (GAS f32x4*)(dout + (smp ? O_CKV_S + (size_t)(r - MP) * 256 : O_CKV_P + (size_t)r * 256) + 4 * lane));
            }
            if (lane < 16) {
                *(GAS f32x2*)(dout + (smp ? O_KR_S + (size_t)(r - MP) * 32 : O_KR_P + (size_t)r * 32) + 2 * lane) = (f32x2){bflo(wk), bfhi(wk)};
            }
            if (smp || t >= 7680) {
                const u32x4 kv = *(const GAS u32x4*)(zr + ZC_KB + 8 * lane), vv = *(const GAS u32x4*)(zr + ZC_VB + 8 * lane);
                GAS float* kd = dout + (smp ? O_BK_S + ((size_t)b * 512 + 448 + t) * 512 : O_BK_P + ((size_t)b * 512 + (t - 7680)) * 512) + 8 * lane;
                GAS float* vd = dout + (smp ? O_BV_S + ((size_t)b * 512 + 448 + t) * 512 : O_BV_P + ((size_t)b * 512 + (t - 7680)) * 512) + 8 * lane;
                *(GAS f32x4*)kd = (f32x4){bflo(kv.x), bfhi(kv.x), bflo(kv.y), bfhi(kv.y)}; *(GAS f32x4*)(kd + 4) = (f32x4){bflo(kv.z), bfhi(kv.z), bflo(kv.w), bfhi(kv.w)};
                *(GAS f32x4*)vd = (f32x4){bflo(vv.x), bfhi(vv.x), bflo(vv.y), bfhi(vv.y)}; *(GAS f32x4*)(vd + 4) = (f32x4){bflo(vv.z), bfhi(vv.z), bflo(vv.w), bfhi(vv.w)};
                if (smp) { *(GAS u32x4*)(KBS + ((size_t)b * 576 + 512 + t) * 512 + 8 * lane) = kv; *(GAS u32x4*)(VBS + ((size_t)b * 576 + 512 + t) * 512 + 8 * lane) = vv; }
            }
        }
    }
#undef P2_LOAD
    SEAM(2);

    if (IN(3)) {
        PHASE_PTRS
        { pg8::Gemm g{Z, WUQ, MT, 768, 384, ZP, 384}; pg8::StaticOrder S; S.init(MT, 768, G, bx);
          pg8::EpiStrip<1> E{QA, 768, (const GAS f32x4*)ropeA, (const GAS f32x4*)ropeC, dout, KCS, VCS};
          PROBE_GEMM_REP pg8::gemm_phase<pg8::EpiStrip<1>, true>(lds, g, S, E); }
        { pg8::Gemm g{Z + ZC_CKV, WUKV, MT, 1024, 256, ZP, 256}; pg8::StaticOrder S; S.init(MT, 1024, G, (bx + (G > 198 ? G - 198 : 0)) % G);
          pg8::EpiStrip<2> E{KVB, 1024, (const GAS f32x4*)ropeA, (const GAS f32x4*)ropeC, dout, KCS, VCS};
          PROBE_GEMM_REP pg8::gemm_phase<pg8::EpiStrip<2>, true>(lds, g, S, E); }
        if (!(858 - 3 * G > 0 && 858 - 3 * G < G))
        { pg8::Gemm g{CACHEC, WUKV, 32768, 1024, 256, 256, 256}; pg8::StaticOrder S; S.init(32768, 1024, G, (bx + 206) % G);
          pg8::EpiStrip<2> E{KVB + (size_t)MT * 1024, 1024, (const GAS f32x4*)ropeA, (const GAS f32x4*)ropeC, dout, KCS, VCS};
          PROBE_GEMM_REP pg8::gemm_phase<pg8::EpiStrip<2>, true>(lds, g, S, E); }
    }
    SEAM(3);

    if (IN(4)) {
        PHASE_PTRS
        const int probe_pass = 0;
        for (;;) {
            const int uq = att::unit_take(lds, att::unit_ask(ctl + 0));
            if (uq >= 576) break;
            const int u = uq < 64 ? 512 + uq : uq - 64;
            att::AUnit U; U.qpitch = 768; U.opitch = ZP; U.kpitch = 1024; U.qpos0 = 0; U.wchunk = 0; U.sink = 0.f; U.nostore = probe_pass;
            if (u < 512) {
                const int qb = 31 - (u >> 4), b = (u >> 3) & 1, h = u & 7; const size_t r0 = (size_t)b * 8192;
                U.t_lo = 0; U.t_hi = 4 * qb + 3; U.t_split = 1 << 30;
                U.k1 = KVB + r0 * 1024 + h * 128; U.v1 = U.k1 + 64; U.kr1 = Z + r0 * ZP + ZC_KR; U.krpitch1 = ZP;
                U.k2 = U.k1; U.v2 = U.v1; U.kr2 = U.kr1; U.krpitch2 = ZP;
                U.wactive = true; U.wt_lo = 0; U.wt_hi = 4 * qb + (wave & 3);
                const size_t qrow = r0 + 256 * qb + 64 * (wave & 3);
                U.q = QA + qrow * 768 + h * 96; U.o = Z + qrow * ZP + ZC_GA + h * 64; U.g = U.o;
            } else {
                const int v = u - 512, b = v >> 3, h = v & 7;
                U.t_lo = 0; U.t_hi = 64; U.t_split = 64;
                U.k1 = KVB + ((size_t)MT + (size_t)b * 4096) * 1024 + h * 128; U.v1 = U.k1 + 64; U.kr1 = KRC + (size_t)b * 4096 * 32; U.krpitch1 = 32;
                const size_t nrow = (size_t)MP + b * 64;
                U.k2 = KVB + nrow * 1024 + h * 128; U.v2 = U.k2 + 64; U.kr2 = Z + nrow * ZP + ZC_KR; U.krpitch2 = ZP;
                U.wactive = (wave & 3) == 0; U.wt_lo = 0; U.wt_hi = 64;
                const size_t qrow = nrow;
                U.q = QA + qrow * 768 + h * 96; U.o = Z + qrow * ZP + ZC_GA + h * 64; U.g = U.o;
            }
            att::attn_unit_mla(lds, U);
        }
        for (;;) {
            const int u = att::unit_take(lds, att::unit_ask(ctl + 64));
            if (u >= 576) break;
            att::AUnit U; U.qpitch = ZP; U.opitch = ZP; U.t_split = 1 << 30; U.sink = 0.f; U.krpitch1 = 0; U.krpitch2 = 0; U.nostore = 0;
            int h;
            if (u < 512) {
                const int qb = 31 - (u >> 4), b = (u >> 3) & 1; h = u & 7; const size_t r0 = (size_t)b * 8192;
                const int cq = 4 * qb + (wave >> 1);
                U.t_lo = max(0, 4 * qb - 8); U.t_hi = 4 * qb + 3; U.kpitch = ZP;
                U.k1 = Z + r0 * ZP + ZC_KB + h * 64; U.v1 = Z + r0 * ZP + ZC_VB + h * 64;
                U.wactive = true; U.wt_lo = max(0, cq - 8); U.wt_hi = cq; U.wchunk = cq; U.qpos0 = 64 * cq + 32 * (wave & 1);
                const size_t qrow = r0 + 256 * qb + 32 * wave;
                U.q = Z + qrow * ZP + ZC_QB + h * 64; U.o = (GAS bf16_t*)U.q; U.g = Z + qrow * ZP + ZC_GB + h * 64;
            } else {
                const int v = u - 512, b = v >> 3; h = v & 7;
                U.t_lo = 0; U.t_hi = 8; U.kpitch = 512;
                U.k1 = KBS + (size_t)b * 576 * 512 + h * 64; U.v1 = VBS + (size_t)b * 576 * 512 + h * 64;
                U.wactive = wave < 2; U.wt_lo = 0; U.wt_hi = 8; U.wchunk = 8; U.qpos0 = 512 + 32 * (wave & 1);
                const size_t qrow = (size_t)MP + b * 64 + 32 * (wave & 1);
                U.q = Z + qrow * ZP + ZC_QB + h * 64; U.o = (GAS bf16_t*)U.q; U.g = Z + qrow * ZP + ZC_GB + h * 64;
            }
            U.k2 = U.k1; U.v2 = U.v1; U.kr1 = U.k1; U.kr2 = U.k1;
            if (tid < 257) ((LAS float*)(lds + att::LDS_BIAS))[tid] = GIN(I_AB_REL)[h * 257 + tid] * LOG2E;
            att::attn_unit<1>(lds, U);
        }
    }
    SEAM(4);

    if (IN(5)) {
        PHASE_PTRS
        { pg8::Gemm g{Z + ZC_GA, WOUT0, MP, 1024, 1024, ZP, 1024}; pg8::StaticOrder S; S.init(MP, 1024, G, bx);
          pg8::EpiStrip<2> E{Y, 1024, (const GAS f32x4*)ropeA, (const GAS f32x4*)ropeC, dout, KCS, VCS};
          PROBE_GEMM_REP pg8::gemm_phase<pg8::EpiStrip<2>, true>(lds, g, S, E); }
        { const int kq = bx & 3, un = (bx >> 2) & 7;
          pg8::Gemm g{Z + ZC_GA + kq * 256, WOUT0 + kq * 256, MT, 1024, 256, ZP, 1024}; pg8::StaticOrder S; S.init_one(bx < 32 ? 64 + (un >> 2) : -2, un & 3);
          pg8::EpiF32 E{YP + (size_t)kq * 524288 - (size_t)MP * 1024, 1024};
          pg8::gemm_phase<pg8::EpiF32, true>(lds, g, S, E); }
        {
            constexpr int J4 = 16 * 72, J5 = 16 * 32;
            LAS float* scr = (LAS float*)(lds + wave * 16384);
            const int nwv = (G > 32 ? G - 32 : G) * 8, wv0 = (G > 32 ? bx - 32 : bx) * 8 + wave;
            if (wv0 >= 0) for (int it = wv0; it < J4 + J5; it += nwv) {
                if (it < J4) transpose_item(GIN(I_C_WIN), 1024, 2304, WIN1, scr, it, lane); else transpose_item(GIN(I_C_WOUT), 1024, 1024, WOUT1, scr, it - J4, lane); }
        }
    }
    SEAM(5);

#ifdef PROBE_R2
    for (int rr_ = 0; rr_ < (a.ph_hi > 5 ? 2 : 1); ++rr_)
#endif
    if (IN(6)) {
        PHASE_PTRS
        const GAS f32x4* pg = (const GAS f32x4*)GIN(I_AB_POST) + lane; const GAS f32x4* ng = (const GAS f32x4*)GIN(I_C_PRE) + lane;
        u32x2 ny[4], my[4]; f32x4 nx[4], mx[4];
#define P6_LOAD(r, ny, nx) do { const GAS f32x4* xr_ = (const GAS f32x4*)((r) < MP ? GIN(I_XP) + (size_t)(r) * DM : GIN(I_XS) + (size_t)((r) - MP) * DM) + lane; \
            _Pragma("unroll") for (int j = 0; j < 4; ++j) nx[j] = __builtin_nontemporal_load(xr_ + 64 * j); \
            if ((r) < MP) { const GAS u32x2* yr_ = (const GAS u32x2*)(Y + (size_t)(r) * DM) + lane; _Pragma("unroll") for (int j = 0; j < 4; ++j) ny[j] = __builtin_nontemporal_load(yr_ + 64 * j); } \
            else { const GAS f32x4* pr_ = (const GAS f32x4*)(YP + (size_t)((r) - MP) * DM) + lane;     \
                _Pragma("unroll") for (int j = 0; j < 4; ++j) { const f32x4 t_ = (pr_[64 * j] + pr_[64 * j + 131072]) + (pr_[64 * j + 262144] + pr_[64 * j + 393216]); ny[j] = (u32x2){pk2(t_.x, t_.y), pk2(t_.z, t_.w)}; } } } while (0)
        if (gw < MT) P6_LOAD(gw, ny, nx);
        if (gw + NGW < MT) P6_LOAD(gw + NGW, my, mx);
        for (int r = gw; r < MT; r += NGW) {
            f32x4 v[4], x[4]; float s = 0.f;
#pragma unroll
            for (int j = 0; j < 4; ++j) { v[j] = (f32x4){bflo(ny[j].x), bfhi(ny[j].x), bflo(ny[j].y), bfhi(ny[j].y)}; x[j] = nx[j]; s += (v[j].x * v[j].x + v[j].y * v[j].y) + (v[j].z * v[j].z + v[j].w * v[j].w); }
#pragma unroll
            for (int j = 0; j < 4; ++j) { ny[j] = my[j]; nx[j] = mx[j]; }
            if (r + 2 * NGW < MT) P6_LOAD(r + 2 * NGW, my, mx);
            const float rstd = 1.0f / sqrtf(wave_sum(s) * (1.f / DM) + RMS_EPS);
            float s2 = 0.f;
#pragma unroll
            for (int j = 0; j < 4; ++j) { v[j] = x[j] + v[j] * rstd * pg[64 * j]; s2 += (v[j].x * v[j].x + v[j].y * v[j].y) + (v[j].z * v[j].z + v[j].w * v[j].w); }
            const float rstd2 = 1.0f / sqrtf(wave_sum(s2) * (1.f / DM) + RMS_EPS);
            GAS u32x2* hr = (GAS u32x2*)(H1 + (size_t)r * DM) + lane; GAS u32x2* o8 = (GAS u32x2*)(XN1 + (size_t)r * DM) + lane;
#pragma unroll
            for (int j = 0; j < 4; ++j) { __builtin_nontemporal_store((u32x2){pk2(v[j].x, v[j].y), pk2(v[j].z, v[j].w)}, hr + 64 * j); const f32x4 g = ng[64 * j];
                o8[64 * j] = (u32x2){pk2(v[j].x * rstd2 * g.x, v[j].y * rstd2 * g.y), pk2(v[j].z * rstd2 * g.z, v[j].w * rstd2 * g.w)}; }
        }
#undef P6_LOAD
    }
    SEAM(6);

    if (IN(7)) {
        PHASE_PTRS
        pg8::Gemm g{XN1, WIN1, MT, Z1P, 1024, 1024, 1024}; pg8::StaticOrder S; S.init(MT, Z1P, G, bx);
        pg8::EpiStrip<3> E{Z, Z1P, (const GAS f32x4*)ropeA, (const GAS f32x4*)ropeC, dout, KCS, VCS};
        PROBE_GEMM_REP pg8::gemm_phase<pg8::EpiStrip<3>, true>(lds, g, S, E);
    }
    SEAM(7);

    if (IN(8)) {
        PHASE_PTRS
        for (int u = bx; u < 1056; u += G) {
            att::AUnit U; U.qpitch = Z1P; U.opitch = Z1P; U.t_split = 1 << 30; U.krpitch1 = 0; U.krpitch2 = 0; U.qpos0 = 0; U.wchunk = 0; U.nostore = 0;
            int qh; size_t qrow;
            if (u < 1024) {
                const int half = u & 1, hk = (u >> 1) & 1, b = (u >> 2) & 1, c = 127 - (u >> 3); const size_t r0 = (size_t)b * 8192;
                U.t_lo = max(0, c - 2); U.t_hi = c; U.kpitch = Z1P;
                U.k1 = Z + r0 * Z1P + Z1_K + hk * 64; U.v1 = Z + r0 * Z1P + Z1_V + hk * 64;
                qh = hk * 8 + half * 4 + (wave >> 1); qrow = r0 + 64 * c + 32 * (wave & 1);
            } else {
                const int v = u - 1024, half = v & 1, hk = (v >> 1) & 1, b = v >> 2;
                U.t_lo = 0; U.t_hi = 2; U.kpitch = 128;
                U.k1 = KCS + (size_t)b * 192 * 128 + hk * 64; U.v1 = VCS + (size_t)b * 192 * 128 + hk * 64;
                qh = hk * 8 + half * 4 + (wave >> 1); qrow = (size_t)MP + b * 64 + 32 * (wave & 1);
            }
            U.wactive = true; U.wt_lo = U.t_lo; U.wt_hi = U.t_hi;
            U.k2 = U.k1; U.v2 = U.v1; U.kr1 = U.k1; U.kr2 = U.k1;
            U.q = Z + qrow * Z1P + qh * 64; U.o = (GAS bf16_t*)U.q; U.g = Z + qrow * Z1P + Z1_G + qh * 64;
            U.sink = GIN(I_C_SINKS)[qh] * LOG2E;
            att::attn_unit<2>(lds, U);
        }
    }
    SEAM(8);

    if (IN(9)) {
        PHASE_PTRS
        { pg8::Gemm g{Z, WOUT1, MP, 1024, 1024, Z1P, 1024}; pg8::StaticOrder S; S.init(MP, 1024, G, bx);
          pg8::EpiStrip<2> E{Y, 1024, (const GAS f32x4*)ropeA, (const GAS f32x4*)ropeC, dout, KCS, VCS};
          PROBE_GEMM_REP pg8::gemm_phase<pg8::EpiStrip<2>, true>(lds, g, S, E); }
        { const int kq = bx & 3, un = (bx >> 2) & 7;
          pg8::Gemm g{Z + kq * 256, WOUT1 + kq * 256, MT, 1024, 256, Z1P, 1024}; pg8::StaticOrder S; S.init_one(bx < 32 ? 64 + (un >> 2) : -2, un & 3);
          pg8::EpiF32 E{YP + (size_t)kq * 524288 - (size_t)MP * 1024, 1024};
          pg8::gemm_phase<pg8::EpiF32, true>(lds, g, S, E); }
    }
    SEAM(9);

    if (IN(10)) {
        PHASE_PTRS
        const GAS f32x4* pg = (const GAS f32x4*)GIN(I_C_POST) + lane;
        u32x2 ny[4], my[4]; u32x2 nh[4], mh[4];
#define P10_LOAD(r, ny, nh) do { const GAS u32x2* hr_ = (const GAS u32x2*)(H1 + (size_t)(r) * DM) + lane; \
            _Pragma("unroll") for (int j = 0; j < 4; ++j) nh[j] = __builtin_nontemporal_load(hr_ + 64 * j); \
            if ((r) < MP) { const GAS u32x2* yr_ = (const GAS u32x2*)(Y + (size_t)(r) * DM) + lane; _Pragma("unroll") for (int j = 0; j < 4; ++j) ny[j] = __builtin_nontemporal_load(yr_ + 64 * j); } \
            else { const GAS f32x4* pr_ = (const GAS f32x4*)(YP + (size_t)((r) - MP) * DM) + lane; \
                _Pragma("unroll") for (int j = 0; j < 4; ++j) { const f32x4 t_ = (pr_[64 * j] + pr_[64 * j + 131072]) + (pr_[64 * j + 262144] + pr_[64 * j + 393216]); ny[j] = (u32x2){pk2(t_.x, t_.y), pk2(t_.z, t_.w)}; } } } while (0)
        if (gw < MT) P10_LOAD(gw, ny, nh);
        if (gw + NGW < MT) P10_LOAD(gw + NGW, my, mh);
        for (int r = gw; r < MT; r += NGW) {
            f32x4 v[4], h[4]; float s = 0.f;
#pragma unroll
            for (int j = 0; j < 4; ++j) { v[j] = (f32x4){bflo(ny[j].x), bfhi(ny[j].x), bflo(ny[j].y), bfhi(ny[j].y)}; h[j] = (f32x4){bflo(nh[j].x), bfhi(nh[j].x), bflo(nh[j].y), bfhi(nh[j].y)}; s += (v[j].x * v[j].x + v[j].y * v[j].y) + (v[j].z * v[j].z + v[j].w * v[j].w); }
#pragma unroll
            for (int j = 0; j < 4; ++j) { ny[j] = my[j]; nh[j] = mh[j]; }
            if (r + 2 * NGW < MT) P10_LOAD(r + 2 * NGW, my, mh);
            const float rstd = 1.0f / sqrtf(wave_sum(s) * (1.f / DM) + RMS_EPS);
            GAS f32x4* hr = (GAS f32x4*)(dout + O_Y + (size_t)r * DM) + lane;
#pragma unroll
            for (int j = 0; j < 4; ++j) __builtin_nontemporal_store(h[j] + v[j] * rstd * pg[64 * j], hr + 64 * j);
        }
#undef P10_LOAD
    }
#undef IN
#undef SEAM
}

extern "C" void kernel_launch(void* const* d_in, const int* in_sizes, int n_in, void* d_out, int out_size, void* d_ws, size_t ws_size, hipStream_t stream) {
    constexpr int LDS_BYTES = 136 * 1024;
    static int grid = 0;
    if (grid == 0) {
        if (n_in != 22 || ws_size < WS_END) { fprintf(stderr, "kernel_launch: unexpected n_in %d / ws_size %zu\n", n_in, ws_size); grid = -1; return; }
        int dev = 0, cus = 0, per_cu = 0;
        (void)hipGetDevice(&dev);
        (void)hipDeviceGetAttribute(&cus, hipDeviceAttributeMultiprocessorCount, dev);
        (void)hipFuncSetAttribute((const void*)mega_fwd, hipFuncAttributeMaxDynamicSharedMemorySize, LDS_BYTES);
        (void)hipOccupancyMaxActiveBlocksPerMultiprocessor(&per_cu, (const void*)mega_fwd, 512, LDS_BYTES);
        if (per_cu < 1) { fprintf(stderr, "kernel_launch: occupancy query says %d blocks per CU\n", per_cu); per_cu = 1; }
        grid = cus * per_cu;
        (void)hipGetLastError();
    }
    if (grid < 0) return;
    (void)hipMemsetAsync((char*)d_ws + WS_CTL, 0, 64 * 1024, stream);
    Args a{};
    for (int i = 0; i < 22; ++i) a.in[i] = (const float*)d_in[i];
    a.out = (float*)d_out; a.ws = (unsigned char*)d_ws; a.ph_lo = 0; a.ph_hi = 11;
    void* args[] = {&a};
    hipError_t e = hipLaunchCooperativeKernel((const void*)mega_fwd, dim3(grid), dim3(512), args, LDS_BYTES, stream);
    if (e != hipSuccess) fprintf(stderr, "kernel_launch: cooperative launch failed: %s (grid %d)\n", hipGetErrorString(e), grid);
}
```

```cpp
#include <hip/hip_runtime.h>
#include <hip/hip_cooperative_groups.h>
#include <cstdio>
#include <cstdint>
#include <cmath>
namespace cg = cooperative_groups;

#define LAS __attribute__((address_space(3)))
#define GAS __attribute__((address_space(1)))
typedef unsigned short bf16_t;
typedef short bf16x8 __attribute__((ext_vector_type(8)));
typedef short s16x4 __attribute__((ext_vector_type(4)));
typedef float f32x4 __attribute__((ext_vector_type(4)));
typedef float f32x2 __attribute__((ext_vector_type(2)));
typedef float f32x16 __attribute__((ext_vector_type(16)));
typedef unsigned u32x4 __attribute__((ext_vector_type(4)));
typedef unsigned u32x2 __attribute__((ext_vector_type(2)));
typedef __bf16 bf16x2_t __attribute__((ext_vector_type(2)));

constexpr int MP = 16384, MS = 512, MT = MP + MS;
constexpr int DM = 1024;
constexpr int ZP = 3328;
constexpr int Z1P = 2304;
constexpr int ZC_CKV = 384, ZC_KR = 640, ZC_GA = 704, ZC_QB = 1216, ZC_KB = 1728, ZC_VB = 2240, ZC_GB = 2752;
constexpr int Z1_K = 1024, Z1_V = 1152, Z1_G = 1280;
constexpr float LOG2E = 1.4426950408889634f;
constexpr float A_SC = 0.10206207261596575f * LOG2E;
constexpr float B_SC = 0.125f * LOG2E;
constexpr float C_SC = 0.125f * LOG2E;
constexpr float RMS_EPS = 1e-6f;
constexpr size_t O_Y = 0, O_CKV_P = 17301504, O_KR_P = 21495808, O_BK_P = 22020096, O_BV_P = 22544384, O_CK_P = 23068672, O_CV_P = 23101440,
                 O_CKV_S = 23134208, O_KR_S = 23265280, O_BK_S = 23281664, O_BV_S = 25378816, O_CK_S = 27475968, O_CV_S = 27607040;
constexpr size_t KiB = 1024, MiB = 1024 * 1024;
constexpr size_t WS_CTL = 0, WS_ROPEA = 64 * KiB, WS_ROPEC = 64 * KiB + 1 * MiB, WS_WIN0 = 2 * MiB, WS_WUQ = 8 * MiB + 512 * KiB, WS_WUKV = 9 * MiB + 256 * KiB,
                 WS_WOUT0 = 10 * MiB, WS_WIN1 = 12 * MiB, WS_WOUT1 = 16 * MiB + 512 * KiB, WS_KCS = 18 * MiB + 512 * KiB, WS_VCS = WS_KCS + 384 * KiB,
                 WS_Z = 20 * MiB, WS_KVB = 128 * MiB, WS_CACHEC = 225 * MiB, WS_KRC = 241 * MiB, WS_KBS = 243 * MiB, WS_VBS = 247 * MiB + 512 * KiB,
                 WS_Y = 128 * MiB, WS_H1 = 161 * MiB  , WS_XN1 = 194 * MiB, WS_YP = 228 * MiB  , WS_END = 252 * MiB;
constexpr size_t DO_XN0 = 0, DO_QA = 34 * MiB;

__device__ __forceinline__ unsigned pk2(float lo, float hi) { f32x2 v = {lo, hi}; bf16x2_t b = __builtin_convertvector(v, bf16x2_t); return __builtin_bit_cast(unsigned, b); }
__device__ __forceinline__ float bflo(unsigned w) { return __uint_as_float(w << 16); }
__device__ __forceinline__ float bfhi(unsigned w) { return __uint_as_float(w & 0xffff0000u); }
__device__ __forceinline__ float wave_sum(float v) {
#pragma unroll
    for (int o = 1; o < 64; o <<= 1) v += __shfl_xor(v, o);
    return v;
}
__device__ __forceinline__ float silu_f(float x) { return x * __builtin_amdgcn_rcpf(1.0f + __builtin_amdgcn_exp2f(-x * LOG2E)); }
__device__ __forceinline__ int row_pos(int row) { return row < MP ? (row & 8191) : 4096 + ((row - MP) & 63); }

namespace pg8 {
constexpr int BM = 256, BK = 64, HALF = 128, HTB = HALF * BK * 2, STAGE_BYTES = 8 * HTB, NXCD = 8, WGM = 8;
__host__ __device__ __forceinline__ int lds_byte(int r, int c) { const int st = (r >> 4) * 2 + (c >> 5), rr = r & 15, cc = c & 31, ob = rr * 64 + cc * 2; return st * 1024 + (ob ^ (((ob >> 9) & 1) << 5)); }
__host__ __device__ __forceinline__ void stage_rc(int b, int& R, int& C) { const int st = b / 1024, sb = b % 1024, swz = sb ^ (((sb >> 9) & 1) << 5); R = (st >> 1) * 16 + swz / 64; C = (st & 1) * 32 + (swz % 64) / 2; }
__host__ __device__ __forceinline__ int perm32(int rho) { const int n = rho >> 4, i = rho & 15; return 8 * (i >> 2) + 4 * n + (i & 3); }
struct Unit { int pm, pn; };
struct Gemm { const GAS bf16_t* A; const GAS bf16_t* Bt; int M, N, K, lda, ldb; };
struct StaticOrder {
    int nM, nN, nwg, G, c, one_pm, one_pn;
    __device__ void init(int M, int N, int G_, int c_) { nM = M / BM; nN = N / BM; nwg = nM * nN; G = G_; c = c_; one_pm = -1; one_pn = 0; }
    __device__ void init_one(int pm, int pn) { nM = nN = nwg = G = 1; c = 0; one_pm = pm; one_pn = pn; }
    __device__ bool next(int i, Unit& u) const {
        if (one_pm != -1) { if (i > 0 || one_pm < 0) return false; u.pm = one_pm; u.pn = one_pn; return true; }
        const long L = (long)i * G + c; if (L >= nwg) return false;
        int wgid = (int)L; { const int q = nwg / NXCD, r = nwg % NXCD, xcd = wgid % NXCD, off = wgid / NXCD; wgid = (xcd < r ? xcd * (q + 1) : r * (q + 1) + (xcd - r) * q) + off; }
        const int nig = WGM * nN, gid = wgid / nig, fm = gid * WGM, gsz = (nM - fm) < WGM ? (nM - fm) : WGM;
        u.pm = fm + ((wgid % nig) % gsz); u.pn = (wgid % nig) / gsz; return true;
    }
};
template <class Epi, bool ALIGN_EPI>
__device__ __forceinline__ void gemm_phase(LAS unsigned char* lds, const Gemm g, const StaticOrder& S, const Epi& E) {
    int tid = threadIdx.x; asm volatile("" : "+v"(tid));
    const int wid = __builtin_amdgcn_readfirstlane(tid >> 6), lane = tid & 63, wr = wid >> 2, wc = wid & 3, fr = lane & 15, fq = lane >> 4;
    const int K = g.K; int nt = K / BK; asm volatile("" : "+s"(nt));
    unsigned voffA[2], voffB[2];
#pragma unroll
    for (int i = 0; i < 2; ++i) { int R, C; stage_rc(tid * 16 + i * 8192, R, C); const int Rb = Epi::PERM ? ((R & ~31) + perm32(R & 31)) : R;
        voffA[i] = (unsigned)(R * g.lda + C) * 2u; voffB[i] = (unsigned)(Rb * g.ldb + C) * 2u; }
    const size_t kstep = (size_t)(BK * 2);
    const size_t hstepA = (size_t)HALF * g.lda * 2, hstepB = (size_t)HALF * g.ldb * 2;
    const size_t tstepA = 2 * hstepA, tstepB = 2 * hstepB;
    const unsigned ldsw = (unsigned)wid * 1024u;
    const int aoff = lds_byte(wr * 64 + fr, fq * 8), boff = lds_byte(wc * 32 + fr, fq * 8);
#define PG8_SA(b, h) (((b) * 2 + (h)) * HTB)
#define PG8_SB(b, h) ((4 + (b) * 2 + (h)) * HTB)
#define PG8_STAGE(bufoff, gbase, voff) do { _Pragma("unroll") for (int _i = 0; _i < 2; ++_i) \
        __builtin_amdgcn_global_load_lds((const GAS unsigned*)((const GAS char*)(gbase) + (voff)[_i]), (LAS unsigned*)(lds + (bufoff) + ldsw + _i * 8192), 16, 0, 0); } while (0)
#define PG8_LDA(dst, b, h) do { _Pragma("unroll") for (int m = 0; m < 4; ++m) _Pragma("unroll") for (int k = 0; k < 2; ++k) dst[m][k] = *(const LAS bf16x8*)(lds + PG8_SA(b, h) + aoff + m * 2048 + k * 1024); } while (0)
#define PG8_LDB(dst, b, h) do { _Pragma("unroll") for (int n = 0; n < 2; ++n) _Pragma("unroll") for (int k = 0; k < 2; ++k) dst[n][k] = *(const LAS bf16x8*)(lds + PG8_SB(b, h) + boff + n * 2048 + k * 1024); } while (0)
#define PG8_MMA(ai, bj, At, Bt) do { __builtin_amdgcn_s_setprio(1); _Pragma("unroll") for (int m = 0; m < 4; ++m) _Pragma("unroll") for (int n = 0; n < 2; ++n) _Pragma("unroll") for (int k = 0; k < 2; ++k) \
        acc[ai][bj][m][n] = __builtin_amdgcn_mfma_f32_16x16x32_bf16(Bt[n][k], At[m][k], acc[ai][bj][m][n], 0, 0, 0); __builtin_amdgcn_s_setprio(0); } while (0)
#define PG8_WAIT_V(n) asm volatile("s_waitcnt vmcnt(" #n ")" ::: "memory")
#define PG8_WAIT_L(n) asm volatile("s_waitcnt lgkmcnt(" #n ")" ::: "memory")
#define PG8_BAR __builtin_amdgcn_s_barrier()
#define PG8_SCHED __builtin_amdgcn_sched_barrier(0)
    Unit cur, nxt; int ui = 0;
    if (!S.next(0, cur)) return;
    f32x4 acc[2][2][4][2];
#pragma unroll
    for (int a = 0; a < 2; ++a)
#pragma unroll
        for (int b = 0; b < 2; ++b)
#pragma unroll
            for (int m = 0; m < 4; ++m)
#pragma unroll
                for (int n = 0; n < 2; ++n) acc[a][b][m][n] = (f32x4){0.f, 0.f, 0.f, 0.f};
    bf16x8 At[4][2], B0[2][2], B1[2][2];
    const GAS char* cA = (const GAS char*)g.A + (size_t)cur.pm * tstepA; const GAS char* cB = (const GAS char*)g.Bt + (size_t)cur.pn * tstepB;
    PG8_STAGE(PG8_SB(0, 0), cB, voffB); PG8_STAGE(PG8_SB(0, 1), cB + hstepB, voffB); PG8_STAGE(PG8_SA(0, 0), cA, voffA); PG8_STAGE(PG8_SA(0, 1), cA + hstepA, voffA);
    if (wr == 1) PG8_BAR;
    PG8_WAIT_V(2); PG8_BAR;
    PG8_STAGE(PG8_SB(1, 0), cB + kstep, voffB); PG8_STAGE(PG8_SA(1, 0), cA + kstep, voffA); PG8_STAGE(PG8_SB(1, 1), cB + hstepB + kstep, voffB);
    PG8_WAIT_V(6); PG8_BAR;
    for (;;) {
        const bool has_next = S.next(ui + 1, nxt);
        const GAS char* nA = has_next ? (const GAS char*)g.A + (size_t)nxt.pm * tstepA : cA; const GAS char* nB = has_next ? (const GAS char*)g.Bt + (size_t)nxt.pn * tstepB : cB;
#pragma unroll 1
        for (int t = 0; t < nt; t += 2) {
            const bool last = (t == nt - 2);
            const GAS char* a1 = cA + (size_t)(t + 1) * kstep;
            const GAS char* a2 = last ? nA : cA + (size_t)(t + 2) * kstep; const GAS char* b2 = last ? nB : cB + (size_t)(t + 2) * kstep;
            const GAS char* a3 = a2 + kstep; const GAS char* b3 = b2 + kstep;
            PG8_LDB(B0, 0, 0); PG8_LDB(B1, 0, 1); PG8_SCHED; PG8_LDA(At, 0, 0); PG8_STAGE(PG8_SA(1, 1), a1 + hstepA, voffA);
            PG8_WAIT_V(8); PG8_WAIT_L(0); PG8_BAR; PG8_MMA(0, 0, At, B0); PG8_MMA(0, 1, At, B1); PG8_BAR; PG8_SCHED;
            PG8_LDA(At, 0, 1); PG8_STAGE(PG8_SB(0, 0), b2, voffB); PG8_STAGE(PG8_SB(0, 1), b2 + hstepB, voffB); PG8_STAGE(PG8_SA(0, 0), a2, voffA);
            PG8_WAIT_V(8); PG8_WAIT_L(0); PG8_BAR; PG8_MMA(1, 0, At, B0); PG8_MMA(1, 1, At, B1); PG8_BAR; PG8_SCHED;
            PG8_LDB(B0, 1, 0); PG8_LDB(B1, 1, 1); PG8_SCHED; PG8_LDA(At, 1, 0); PG8_STAGE(PG8_SA(0, 1), a2 + hstepA, voffA);
            PG8_WAIT_V(8); PG8_WAIT_L(0); PG8_BAR; PG8_MMA(0, 0, At, B0); PG8_MMA(0, 1, At, B1); PG8_BAR; PG8_SCHED;
            PG8_LDA(At, 1, 1); PG8_STAGE(PG8_SB(1, 0), b3, voffB); PG8_STAGE(PG8_SB(1, 1), b3 + hstepB, voffB); PG8_STAGE(PG8_SA(1, 0), a3, voffA);
            PG8_WAIT_V(8); PG8_WAIT_L(0); PG8_BAR; PG8_MMA(1, 0, At, B0); PG8_MMA(1, 1, At, B1); PG8_BAR; PG8_SCHED;
        }
        if constexpr (ALIGN_EPI) { if (wr == 0) PG8_BAR; }
        E(acc, cur, wr, wc, fr, fq);
        if (!has_next) break;
#pragma unroll
        for (int a = 0; a < 2; ++a)
#pragma unroll
            for (int b = 0; b < 2; ++b)
#pragma unroll
                for (int m = 0; m < 4; ++m)
#pragma unroll
                    for (int n = 0; n < 2; ++n) acc[a][b][m][n] = (f32x4){0.f, 0.f, 0.f, 0.f};
        cur = nxt; cA = nA; cB = nB; ++ui;
        if constexpr (ALIGN_EPI) { if (wr == 1) PG8_BAR; }
    }
    PG8_WAIT_V(0);
    if constexpr (!ALIGN_EPI) { if (wr == 0) PG8_BAR; }
    PG8_BAR;
#undef PG8_SA
#undef PG8_SB
#undef PG8_STAGE
#undef PG8_LDA
#undef PG8_LDB
#undef PG8_MMA
#undef PG8_WAIT_V
#undef PG8_WAIT_L
#undef PG8_BAR
#undef PG8_SCHED
}

struct EpiF32 {
    static constexpr bool PERM = false;
    GAS float* O; int ldc;
    __device__ __forceinline__ void operator()(const f32x4 (&acc)[2][2][4][2], const Unit& u, int wr, int wc, int fr, int fq) const {
#pragma unroll
        for (int ai = 0; ai < 2; ++ai)
#pragma unroll
            for (int m = 0; m < 4; ++m) { GAS float* rowp = O + (size_t)(u.pm * BM + ai * HALF + wr * 64 + m * 16 + fr) * ldc + u.pn * BM + wc * 32 + 4 * fq;
#pragma unroll
                for (int bj = 0; bj < 2; ++bj)
#pragma unroll
                    for (int n = 0; n < 2; ++n) *(GAS f32x4*)(rowp + bj * HALF + n * 16) = acc[ai][bj][m][n]; }
    }
};
enum { M_ID = 0, M_SCALE = 1, M_SILU = 2, M_ROPE32 = 3, M_ROPE16 = 4, M_SKIP = 5 };
template <int KIND> struct EpiStrip {
    static constexpr bool PERM = true;
    GAS bf16_t* O; int ldc; const GAS f32x4* ropeA; const GAS f32x4* ropeC; GAS float* dout; GAS bf16_t* kcs; GAS bf16_t* vcs;
    __device__ __forceinline__ void operator()(const f32x4 (&acc)[2][2][4][2], const Unit& u, int wr, int wc, int fr, int fq) const {
#pragma unroll
        for (int bj = 0; bj < 2; ++bj) {
            const int cs = u.pn * BM + bj * HALF + wc * 32;
            const int s = cs >> 5;
            int mode = M_ID; float scale = 1.f;
            if (KIND == 0) { if (s == 20) mode = M_ROPE32; else if (s == 21) mode = M_SKIP; else if ((s >= 22 && s < 38) || (s >= 86 && s < 102)) mode = M_SILU; else if (s >= 38 && s < 54) { mode = M_SCALE; scale = B_SC; } else if (s >= 102) mode = M_SKIP; }
            if (KIND == 1) { scale = A_SC; mode = (s % 3 == 2) ? M_ROPE32 : M_SCALE; }
            if (KIND == 3) { if (s < 32) { scale = C_SC; mode = (s & 1) ? M_SCALE : M_ROPE16; } else if (s < 36) { mode = (s & 1) ? M_ID : M_ROPE16; } else if (s < 40) mode = M_ID; else mode = M_SILU; }
            if (mode == M_SKIP) continue;
            const int c0 = cs + 8 * fq;
#pragma unroll
            for (int ai = 0; ai < 2; ++ai)
#pragma unroll
                for (int m = 0; m < 4; ++m) {
                    const int row = u.pm * BM + ai * HALF + wr * 64 + m * 16 + fr;
                    f32x4 v0 = acc[ai][bj][m][0], v1 = acc[ai][bj][m][1];
                    if (mode == M_SILU) {
#pragma unroll
                        for (int i = 0; i < 4; ++i) { v0[i] = silu_f(v0[i]); v1[i] = silu_f(v1[i]); }
                    } else if (mode == M_ROPE32) {
                        const int pos = row_pos(row);
                        const GAS f32x4* tp = ropeA + (size_t)pos * 8 + (fq & 1) * 4;
                        const f32x4 t0 = tp[0], t1 = tp[1], t2 = tp[2], t3 = tp[3];
                        const float sg = (fq < 2) ? -1.f : 1.f;
                        f32x4 p0, p1;
#pragma unroll
                        for (int i = 0; i < 4; ++i) { p0[i] = __shfl_xor(v0[i], 32); p1[i] = __shfl_xor(v1[i], 32); }
                        v0[0] = v0[0] * t0[0] + sg * p0[0] * t0[1]; v0[1] = v0[1] * t0[2] + sg * p0[1] * t0[3];
                        v0[2] = v0[2] * t1[0] + sg * p0[2] * t1[1]; v0[3] = v0[3] * t1[2] + sg * p0[3] * t1[3];
                        v1[0] = v1[0] * t2[0] + sg * p1[0] * t2[1]; v1[1] = v1[1] * t2[2] + sg * p1[1] * t2[3];
                        v1[2] = v1[2] * t3[0] + sg * p1[2] * t3[1]; v1[3] = v1[3] * t3[2] + sg * p1[3] * t3[3];
                    } else if (mode == M_ROPE16) {
                        const int pos = row_pos(row);
                        const GAS f32x4* tp = ropeC + (size_t)pos * 4;
                        const f32x4 t0 = tp[0], t1 = tp[1], t2 = tp[2], t3 = tp[3];
                        const float sg = (fq == 0) ? -1.f : 1.f;
                        f32x4 p0, p1;
#pragma unroll
                        for (int i = 0; i < 4; ++i) { p0[i] = __shfl_xor(v0[i], 16); p1[i] = __shfl_xor(v1[i], 16); }
                        if (fq < 2) {
                            v0[0] = v0[0] * t0[0] + sg * p0[0] * t0[1]; v0[1] = v0[1] * t0[2] + sg * p0[1] * t0[3];
                            v0[2] = v0[2] * t1[0] + sg * p0[2] * t1[1]; v0[3] = v0[3] * t1[2] + sg * p0[3] * t1[3];
                            v1[0] = v1[0] * t2[0] + sg * p1[0] * t2[1]; v1[1] = v1[1] * t2[2] + sg * p1[1] * t2[3];
                            v1[2] = v1[2] * t3[0] + sg * p1[2] * t3[1]; v1[3] = v1[3] * t3[2] + sg * p1[3] * t3[3];
                        }
                    }
                    if (KIND == 3 && s >= 32 && s < 40) {
                        const int ck = c0 - Z1_K;
                        const bool isv = ck >= 128; const int cc = isv ? ck - 128 : ck;
                        if (row >= MP) {
                            const int bs = (row - MP) >> 6, t = (row - MP) & 63;
                            GAS float* dp = dout + (isv ? O_CV_S : O_CK_S) + ((size_t)bs * 128 + 64 + t) * 128 + cc;
                            *(GAS f32x4*)dp = v0; *(GAS f32x4*)(dp + 4) = v1;
                            GAS bf16_t* bp = (isv ? vcs : kcs) + ((size_t)bs * 192 + 128 + t) * 128 + cc;
                            u32x4 w; w.x = pk2(v0[0], v0[1]); w.y = pk2(v0[2], v0[3]); w.z = pk2(v1[0], v1[1]); w.w = pk2(v1[2], v1[3]);
                            *(GAS u32x4*)bp = w;
                        } else if ((row & 8191) >= 8064) {
                            const int b = row >> 13, p = (row & 8191) - 8064;
                            GAS float* dp = dout + (isv ? O_CV_P : O_CK_P) + ((size_t)b * 128 + p) * 128 + cc;
                            *(GAS f32x4*)dp = v0; *(GAS f32x4*)(dp + 4) = v1;
                        }
                    }
                    if (mode == M_SCALE || ((mode == M_ROPE32 || mode == M_ROPE16) && scale != 1.f)) { v0 = v0 * scale; v1 = v1 * scale; }
                    u32x4 w; w.x = pk2(v0[0], v0[1]); w.y = pk2(v0[2], v0[3]); w.z = pk2(v1[0], v1[1]); w.w = pk2(v1[2], v1[3]);
                    *(GAS u32x4*)(O + (size_t)row * ldc + c0) = w;
                    asm volatile("" ::: "memory");
                }
        }
    }
};
}

namespace att {
constexpr int LDS_K0 = 0  , LDS_V0 = 49152  , LDS_BIAS = 81920, LDS_SCHED = 83968, LDS_OST = 86016  , OSTP = 144;
struct AUnit {
    int t_lo, t_hi, t_split;
    const GAS bf16_t *k1, *k2, *kr1, *kr2, *v1, *v2;
    int kpitch, krpitch1, krpitch2;
    bool wactive; int wt_lo, wt_hi;
    const GAS bf16_t* q; int qpitch;
    GAS bf16_t* o; const GAS bf16_t* g; int opitch;
    int qpos0, wchunk;
    float sink;
    int nostore;
};
__device__ __forceinline__ s16x4 vtr(const LAS char* p) { typedef short v4i16_t __attribute__((ext_vector_type(4))); return __builtin_bit_cast(s16x4, __builtin_amdgcn_ds_read_tr16_b64_v4i16((LAS v4i16_t*)p)); }
__device__ __forceinline__ float xhalf_max(float m) { auto rr = __builtin_amdgcn_permlane32_swap(__float_as_uint(m), __float_as_uint(m), false, false); return fmaxf(__uint_as_float(rr[0]), __uint_as_float(rr[1])); }
__device__ __forceinline__ float xhalf_sum(float m) { auto rr = __builtin_amdgcn_permlane32_swap(__float_as_uint(m), __float_as_uint(m), false, false); return __uint_as_float(rr[0]) + __uint_as_float(rr[1]); }

__device__ __forceinline__ void glds16(const GAS void* gsrc, unsigned lds_dst) { unsigned keep;
    asm volatile("s_mov_b32 %0, m0\n\ts_mov_b32 m0, %2\n\ts_nop 0\n\tglobal_load_lds_dwordx4 %1, off\n\ts_mov_b32 m0, %0" : "=&s"(keep) : "v"(gsrc), "s"(lds_dst) : "memory"); }
constexpr float ATT_THR = 8.f;
#define ATT_WAITV(n) asm volatile("s_waitcnt vmcnt(" #n ") lgkmcnt(0)" ::: "memory")
template <int MODE>
__device__ __forceinline__ void attn_unit(LAS unsigned char* lds, const AUnit& U) {
    constexpr int DQK = (MODE == 0) ? 96 : 64, ND = DQK / 16, KSLOT = (DQK / 8) * 1024, VSLOT = 8192, NPW = (MODE == 0) ? 3 : 2;
    int tid = threadIdx.x; asm volatile("" : "+v"(tid));
    const int lane = tid & 63, w = __builtin_amdgcn_readfirstlane(tid >> 6), r32 = lane & 31, hh = lane >> 5;
    bf16x8 qf[ND];
    float m_ref = (MODE == 2) ? U.sink : 0.f, l = (MODE == 2 && hh == 0) ? 1.f : 0.f;
    bool first = (MODE != 2);
    f32x16 o0, o1, p0, p1, negm;
#pragma unroll
    for (int r = 0; r < 16; ++r) { o0[r] = 0.f; o1[r] = 0.f; p0[r] = 0.f; p1[r] = 0.f; negm[r] = -m_ref; }
    const int krow_ = 8 * w + (lane >> 3);
    const size_t koff = (size_t)krow_ * U.kpitch + (((lane & 7) ^ ((krow_ >> 1) & 7)) * 8);
    const size_t voff = (size_t)(16 * (w & 3) + (lane >> 2)) * U.kpitch + 32 * (w >> 2) + 8 * (lane & 3);
    const size_t roff1 = (size_t)lane * U.krpitch1 + (w & 3) * 8, roff2 = (size_t)lane * U.krpitch2 + (w & 3) * 8;
    const unsigned lds0 = (unsigned)(uintptr_t)lds;
#define ATT_DMA(t, slot) do { const bool s2_ = (t) >= U.t_split; const size_t kk_ = (size_t)(s2_ ? (t) - U.t_split : (t)) * 64; \
        glds16((s2_ ? U.k2 : U.k1) + kk_ * U.kpitch + koff, (unsigned)__builtin_amdgcn_readfirstlane(lds0 + LDS_K0 + (slot) * KSLOT + w * 1024)); \
        if (MODE == 0) glds16(s2_ ? U.kr2 + kk_ * U.krpitch2 + roff2 : U.kr1 + kk_ * U.krpitch1 + roff1, (unsigned)__builtin_amdgcn_readfirstlane(lds0 + LDS_K0 + (slot) * KSLOT + (8 + (w & 3)) * 1024)); \
        glds16((s2_ ? U.v2 : U.v1) + kk_ * U.kpitch + voff, (unsigned)__builtin_amdgcn_readfirstlane(lds0 + LDS_V0 + (slot) * VSLOT + w * 1024)); } while (0)
#define ACTIVE(j) (U.wactive && (j) >= U.wt_lo && (j) <= U.wt_hi)
#define ATT_WAIT_BAR(ahead) do { if ((ahead) >= 2) { if (NPW == 3) ATT_WAITV(6); else ATT_WAITV(4); } else if ((ahead) == 1) { if (NPW == 3) ATT_WAITV(3); else ATT_WAITV(2); } else ATT_WAITV(0); \
        __builtin_amdgcn_s_barrier(); asm volatile("" ::: "memory"); } while (0)
#define ATT_QKMAX(j, slot) do { \
        const LAS unsigned char* kq = lds + LDS_K0 + (slot) * KSLOT + r32 * 128; \
        _Pragma("unroll") for (int d0 = 0; d0 < ND; ++d0) { const int sw_ = (((2 * d0 + hh) ^ ((r32 >> 1) & 7)) & 7) * 16 + (d0 >= 4 ? 8192 : 0); \
            const bf16x8 ka = *(const LAS bf16x8*)(kq + sw_), kb2 = *(const LAS bf16x8*)(kq + 4096 + sw_); \
            p0 = __builtin_amdgcn_mfma_f32_32x32x16_bf16(ka, qf[d0], d0 == 0 ? negm : p0, 0, 0, 0); \
            p1 = __builtin_amdgcn_mfma_f32_32x32x16_bf16(kb2, qf[d0], d0 == 0 ? negm : p1, 0, 0, 0); } \
        if (MODE == 1) { const LAS float* bl = (const LAS float*)(lds + LDS_BIAS); \
            if (U.wchunk - (j) >= 3) { const float bc = bl[256]; _Pragma("unroll") for (int r = 0; r < 16; ++r) { p0[r] += bc; p1[r] += bc; } } \
            else { const int rel0 = U.qpos0 + r32 - 64 * (j) - 4 * hh; \
                _Pragma("unroll") for (int r = 0; r < 16; ++r) { const int rel = rel0 - ((r & 3) + 8 * (r >> 2)); \
                    p0[r] += bl[min(max(rel, -128), 128) + 128]; p1[r] += bl[min(max(rel - 32, -128), 128) + 128]; } } } \
        float rm = fmaxf(p0[0], p1[0]); \
        _Pragma("unroll") for (int r = 1; r < 16; ++r) rm = fmaxf(rm, fmaxf(p0[r], p1[r])); \
        rm = xhalf_max(rm); \
        if (first || __builtin_amdgcn_ballot_w64(rm > ATT_THR) != 0ull) { \
            const float dl = first ? rm : fmaxf(rm, 0.f); \
            m_ref += dl; \
            _Pragma("unroll") for (int r = 0; r < 16; ++r) { p0[r] -= dl; p1[r] -= dl; } \
            if (!first) { const float f = __builtin_amdgcn_exp2f(-dl); l *= f; \
                _Pragma("unroll") for (int r = 0; r < 16; ++r) { o0[r] *= f; o1[r] *= f; } } \
            _Pragma("unroll") for (int r = 0; r < 16; ++r) negm[r] = -m_ref; \
            first = false; } } while (0)
#define ATT_EXPPV(slot) do { \
        float ps = 0.f; \
        _Pragma("unroll") for (int r = 0; r < 16; ++r) { p0[r] = __builtin_amdgcn_exp2f(p0[r]); p1[r] = __builtin_amdgcn_exp2f(p1[r]); ps += p0[r] + p1[r]; } \
        l += ps; \
        u32x4 pw[4]; \
        pw[0] = (u32x4){pk2(p0[0], p0[1]), pk2(p0[2], p0[3]), pk2(p0[4], p0[5]), pk2(p0[6], p0[7])}; \
        pw[1] = (u32x4){pk2(p0[8], p0[9]), pk2(p0[10], p0[11]), pk2(p0[12], p0[13]), pk2(p0[14], p0[15])}; \
        pw[2] = (u32x4){pk2(p1[0], p1[1]), pk2(p1[2], p1[3]), pk2(p1[4], p1[5]), pk2(p1[6], p1[7])}; \
        pw[3] = (u32x4){pk2(p1[8], p1[9]), pk2(p1[10], p1[11]), pk2(p1[12], p1[13]), pk2(p1[14], p1[15])}; \
        const LAS char* vq = (const LAS char*)lds + LDS_V0 + (slot) * VSLOT + ((lane >> 4) & 1) * 32 + (lane & 3) * 8 + (4 * hh + ((lane & 15) >> 2)) * 64; \
        _Pragma("unroll") for (int kg = 0; kg < 4; ++kg) { \
            const bf16x8 pb = __builtin_bit_cast(bf16x8, pw[kg]); \
            const s16x4 a0 = vtr(vq + kg * 1024), a1 = vtr(vq + kg * 1024 + 512), b0 = vtr(vq + 4096 + kg * 1024), b1 = vtr(vq + 4096 + kg * 1024 + 512); \
            const bf16x8 vf0 = (bf16x8){a0[0], a0[1], a0[2], a0[3], a1[0], a1[1], a1[2], a1[3]}; \
            const bf16x8 vf1 = (bf16x8){b0[0], b0[1], b0[2], b0[3], b1[0], b1[1], b1[2], b1[3]}; \
            o0 = __builtin_amdgcn_mfma_f32_32x32x16_bf16(vf0, pb, o0, 0, 0, 0); \
            o1 = __builtin_amdgcn_mfma_f32_32x32x16_bf16(vf1, pb, o1, 0, 0, 0); } } while (0)
    const int t_lo = U.t_lo, t_hi = U.t_hi;
    ATT_DMA(t_lo, 0);
    if (t_lo + 1 <= t_hi) ATT_DMA(t_lo + 1, 1);
    if (t_lo + 2 <= t_hi) ATT_DMA(t_lo + 2, 2);
    if (MODE != 0 && U.wactive) {
        LAS unsigned char* qs = lds + LDS_OST + w * (32 * OSTP);
        u32x4 qv[4];
#pragma unroll
        for (int i = 0; i < 4; ++i) qv[i] = *(const GAS u32x4*)(U.q + (size_t)(i * 8 + (lane >> 3)) * U.qpitch + (lane & 7) * 8);
#pragma unroll
        for (int i = 0; i < 4; ++i) *(LAS u32x4*)(qs + (i * 8 + (lane >> 3)) * OSTP + (lane & 7) * 16) = qv[i];
        asm volatile("s_waitcnt lgkmcnt(0)" ::: "memory");
#pragma unroll
        for (int d0 = 0; d0 < ND; ++d0) { qf[d0] = *(const LAS bf16x8*)(qs + r32 * OSTP + (2 * d0 + hh) * 16); asm volatile("" : "+v"(qf[d0])); }
    } else {
#pragma unroll
    for (int d0 = 0; d0 < ND; ++d0) { qf[d0] = U.wactive ? *(const GAS bf16x8*)(U.q + (size_t)r32 * U.qpitch + d0 * 16 + hh * 8) : (bf16x8){0, 0, 0, 0, 0, 0, 0, 0};
        asm volatile("" : "+v"(qf[d0])); }
    }
    ATT_WAIT_BAR(min(t_lo + 2, t_hi) - t_lo);
    int slot = 0;
#pragma unroll 1
    for (int i = t_lo; i <= t_hi; ++i) {
        if (i + 3 <= t_hi) ATT_DMA(i + 3, (slot + 3) & 3);
        if (ACTIVE(i)) { ATT_QKMAX(i, slot); ATT_EXPPV(slot); }
        ATT_WAIT_BAR(min(i + 3, t_hi) - (i + 1));
        slot = (slot + 1) & 3;
    }
#undef ATT_DMA
#undef ACTIVE
#undef ATT_WAIT_BAR
#undef ATT_QKMAX
#undef ATT_EXPPV
    if (U.wactive && !U.nostore) {
        l = xhalf_sum(l);
        const float inv = 1.0f / l;
        LAS unsigned char* stg = lds + LDS_OST + w * (32 * OSTP);
#pragma unroll
        for (int rg = 0; rg < 4; ++rg) {
            *(LAS u32x2*)(stg + r32 * OSTP + (8 * rg + 4 * hh) * 2) = (u32x2){pk2(o0[4 * rg] * inv, o0[4 * rg + 1] * inv), pk2(o0[4 * rg + 2] * inv, o0[4 * rg + 3] * inv)};
            *(LAS u32x2*)(stg + r32 * OSTP + (32 + 8 * rg + 4 * hh) * 2) = (u32x2){pk2(o1[4 * rg] * inv, o1[4 * rg + 1] * inv), pk2(o1[4 * rg + 2] * inv, o1[4 * rg + 3] * inv)};
        }
        asm volatile("s_waitcnt lgkmcnt(0)" ::: "memory");
#pragma unroll
        for (int i = 0; i < 4; ++i) {
            const int row = i * 8 + (lane >> 3), ch = lane & 7;
            const u32x4 ov = *(const LAS u32x4*)(stg + row * OSTP + ch * 16);
            const u32x4 gv = *(const GAS u32x4*)(U.g + (size_t)row * U.opitch + ch * 8);
            u32x4 r;
            r.x = pk2(bflo(ov.x) * bflo(gv.x), bfhi(ov.x) * bfhi(gv.x)); r.y = pk2(bflo(ov.y) * bflo(gv.y), bfhi(ov.y) * bfhi(gv.y));
            r.z = pk2(bflo(ov.z) * bflo(gv.z), bfhi(ov.z) * bfhi(gv.z)); r.w = pk2(bflo(ov.w) * bflo(gv.w), bfhi(ov.w) * bfhi(gv.w));
            *(GAS u32x4*)(U.o + (size_t)row * U.opitch + ch * 8) = r;
        }
    }
}
__device__ __forceinline__ void attn_unit_mla(LAS unsigned char* lds, const AUnit& U) {
    constexpr int ND = 6, KSLOT = 12288, VSLOT = 8192;
    int tid = threadIdx.x; asm volatile("" : "+v"(tid));
    const int lane = tid & 63, w = __builtin_amdgcn_readfirstlane(tid >> 6), r32 = lane & 31, hh = lane >> 5;
    const int rg = w & 3, kh = w >> 2;
    bf16x8 qf[2][ND];
    float m_ref[2] = {0.f, 0.f}, l[2] = {0.f, 0.f};
    bool first = true;
    f32x16 o[2][2];
#pragma unroll
    for (int r = 0; r < 16; ++r) { o[0][0][r] = 0.f; o[0][1][r] = 0.f; o[1][0][r] = 0.f; o[1][1][r] = 0.f; }
    const int krow_ = 8 * w + (lane >> 3), rrow_ = 16 * (w & 3) + (lane >> 2);
    const size_t koff = (size_t)krow_ * U.kpitch + (((lane & 7) ^ ((krow_ >> 1) & 7)) * 8);
    const size_t voff = (size_t)(16 * (w & 3) + (lane >> 2)) * U.kpitch + 32 * (w >> 2) + 8 * (lane & 3);
    const int rsw_ = ((lane & 3) ^ ((rrow_ >> 2) & 3)) * 8;
    const size_t roff1 = (size_t)rrow_ * U.krpitch1 + rsw_, roff2 = (size_t)rrow_ * U.krpitch2 + rsw_;
    const unsigned lds0 = (unsigned)(uintptr_t)lds;
#define MLA_DMA(t, slot) do { const bool s2_ = (t) >= U.t_split; const size_t kk_ = (size_t)(s2_ ? (t) - U.t_split : (t)) * 64; \
        glds16((s2_ ? U.k2 : U.k1) + kk_ * U.kpitch + koff, (unsigned)__builtin_amdgcn_readfirstlane(lds0 + LDS_K0 + (slot) * KSLOT + w * 1024)); \
        glds16(s2_ ? U.kr2 + kk_ * U.krpitch2 + roff2 : U.kr1 + kk_ * U.krpitch1 + roff1, (unsigned)__builtin_amdgcn_readfirstlane(lds0 + LDS_K0 + (slot) * KSLOT + (8 + (w & 3)) * 1024)); \
        glds16((s2_ ? U.v2 : U.v1) + kk_ * U.kpitch + voff, (unsigned)__builtin_amdgcn_readfirstlane(lds0 + LDS_V0 + (slot) * VSLOT + w * 1024)); } while (0)
#define MLA_WAIT_BAR(ahead) do { if ((ahead) >= 2) ATT_WAITV(6); else if ((ahead) == 1) ATT_WAITV(3); else ATT_WAITV(0); __builtin_amdgcn_s_barrier(); asm volatile("" ::: "memory"); } while (0)
    const int t_lo = U.t_lo, t_hi = U.t_hi;
    MLA_DMA(t_lo, 0);
    if (t_lo + 1 <= t_hi) MLA_DMA(t_lo + 1, 1);
    if (t_lo + 2 <= t_hi) MLA_DMA(t_lo + 2, 2);
    if (U.wactive) {
        LAS unsigned char* qs = lds + LDS_OST + w * 6144;
#pragma unroll
        for (int rb = 0; rb < 2; ++rb) {
            u32x4 qv[6];
#pragma unroll
            for (int i = 0; i < 6; ++i) { const int e = i * 64 + lane, row = e / 12, ch = e % 12; qv[i] = *(const GAS u32x4*)(U.q + (size_t)(32 * rb + row) * U.qpitch + ch * 8); }
#pragma unroll
            for (int i = 0; i < 6; ++i) { const int e = i * 64 + lane; *(LAS u32x4*)(qs + e * 16) = qv[i]; }
            asm volatile("s_waitcnt lgkmcnt(0)" ::: "memory");
#pragma unroll
            for (int d0 = 0; d0 < ND; ++d0) { qf[rb][d0] = *(const LAS bf16x8*)(qs + r32 * 192 + (2 * d0 + hh) * 16); asm volatile("" : "+v"(qf[rb][d0])); }
            asm volatile("s_waitcnt lgkmcnt(0)" ::: "memory");
        }
    } else {
#pragma unroll
        for (int rb = 0; rb < 2; ++rb)
#pragma unroll
            for (int d0 = 0; d0 < ND; ++d0) qf[rb][d0] = (bf16x8){0, 0, 0, 0, 0, 0, 0, 0};
    }
    MLA_WAIT_BAR(min(t_lo + 2, t_hi) - t_lo);
    int slot = 0;
#pragma unroll 1
    for (int i = t_lo; i <= t_hi; ++i) {
        if (i + 3 <= t_hi) MLA_DMA(i + 3, (slot + 3) & 3);
        if (U.wactive && i >= U.wt_lo && i <= U.wt_hi) {
            f32x16 p[2];
            const LAS unsigned char* kq = lds + LDS_K0 + slot * KSLOT;
            const int krd_ = r32 + 32 * kh;
#pragma unroll
            for (int d0 = 0; d0 < ND; ++d0) {
                const int ko_ = d0 < 4 ? krd_ * 128 + ((((2 * d0 + hh) ^ ((r32 >> 1) & 7)) & 7) * 16) : 8192 + krd_ * 64 + ((((2 * (d0 - 4) + hh) ^ ((r32 >> 2) & 3)) & 3) * 16);
                const bf16x8 kf = *(const LAS bf16x8*)(kq + ko_);
                if (d0 == 0) { f32x16 z;
#pragma unroll
                    for (int r = 0; r < 16; ++r) z[r] = 0.f;
                    p[0] = __builtin_amdgcn_mfma_f32_32x32x16_bf16(kf, qf[0][0], z, 0, 0, 0); p[1] = __builtin_amdgcn_mfma_f32_32x32x16_bf16(kf, qf[1][0], z, 0, 0, 0);
                } else { p[0] = __builtin_amdgcn_mfma_f32_32x32x16_bf16(kf, qf[0][d0], p[0], 0, 0, 0); p[1] = __builtin_amdgcn_mfma_f32_32x32x16_bf16(kf, qf[1][d0], p[1], 0, 0, 0); }
            }
            float rm[2];
#pragma unroll
            for (int rb = 0; rb < 2; ++rb) { float x = p[rb][0];
#pragma unroll
                for (int r = 1; r < 16; ++r) x = fmaxf(x, p[rb][r]);
                rm[rb] = xhalf_max(x); }
            if (first || __builtin_amdgcn_ballot_w64(rm[0] - m_ref[0] > ATT_THR || rm[1] - m_ref[1] > ATT_THR) != 0ull) {
#pragma unroll
                for (int rb = 0; rb < 2; ++rb) { const float mn = first ? rm[rb] : fmaxf(m_ref[rb], rm[rb]);
                    if (!first) { const float f = __builtin_amdgcn_exp2f(m_ref[rb] - mn); l[rb] *= f;
#pragma unroll
                        for (int r = 0; r < 16; ++r) { o[rb][0][r] *= f; o[rb][1][r] *= f; } }
                    m_ref[rb] = mn; }
                first = false;
            }
            u32x4 pw[2][2];
#pragma unroll
            for (int rb = 0; rb < 2; ++rb) { float ps = 0.f;
#pragma unroll
                for (int r = 0; r < 16; ++r) { p[rb][r] = __builtin_amdgcn_exp2f(p[rb][r] - m_ref[rb]); ps += p[rb][r]; }
                l[rb] += ps;
                pw[rb][0] = (u32x4){pk2(p[rb][0], p[rb][1]), pk2(p[rb][2], p[rb][3]), pk2(p[rb][4], p[rb][5]), pk2(p[rb][6], p[rb][7])};
                pw[rb][1] = (u32x4){pk2(p[rb][8], p[rb][9]), pk2(p[rb][10], p[rb][11]), pk2(p[rb][12], p[rb][13]), pk2(p[rb][14], p[rb][15])}; }
            const LAS char* vq = (const LAS char*)lds + LDS_V0 + slot * VSLOT + ((lane >> 4) & 1) * 32 + (lane & 3) * 8 + (4 * hh + ((lane & 15) >> 2)) * 64 + kh * 2048;
#pragma unroll
            for (int ks = 0; ks < 2; ++ks) {
                const s16x4 a0 = vtr(vq + ks * 1024), a1 = vtr(vq + ks * 1024 + 512), b0 = vtr(vq + 4096 + ks * 1024), b1 = vtr(vq + 4096 + ks * 1024 + 512);
                const bf16x8 vf0 = (bf16x8){a0[0], a0[1], a0[2], a0[3], a1[0], a1[1], a1[2], a1[3]};
                const bf16x8 vf1 = (bf16x8){b0[0], b0[1], b0[2], b0[3], b1[0], b1[1], b1[2], b1[3]};
#pragma unroll
                for (int rb = 0; rb < 2; ++rb) { const bf16x8 pb = __builtin_bit_cast(bf16x8, pw[rb][ks]);
                    o[rb][0] = __builtin_amdgcn_mfma_f32_32x32x16_bf16(vf0, pb, o[rb][0], 0, 0, 0);
                    o[rb][1] = __builtin_amdgcn_mfma_f32_32x32x16_bf16(vf1, pb, o[rb][1], 0, 0, 0); }
            }
        }
        MLA_WAIT_BAR(min(i + 3, t_hi) - (i + 1));
        slot = (slot + 1) & 3;
    }
#undef MLA_DMA
#undef MLA_WAIT_BAR
    LAS float* X = (LAS float*)(lds + rg * 17408) + lane;
    if (U.wactive && kh == 1) {
#pragma unroll
        for (int rb = 0; rb < 2; ++rb) { X[(0 + rb) * 64] = first ? -1e30f : m_ref[rb]; X[(2 + rb) * 64] = xhalf_sum(l[rb]);
#pragma unroll
            for (int dh = 0; dh < 2; ++dh)
#pragma unroll
                for (int r = 0; r < 16; ++r) X[(4 + rb * 32 + dh * 16 + r) * 64] = o[rb][dh][r]; }
    }
    asm volatile("s_waitcnt lgkmcnt(0)" ::: "memory"); __builtin_amdgcn_s_barrier(); asm volatile("" ::: "memory");
    if (U.wactive && kh == 0) {
        LAS unsigned char* stg = lds + LDS_OST + rg * (64 * OSTP);
#pragma unroll
        for (int rb = 0; rb < 2; ++rb) {
            const float m0 = first ? -1e30f : m_ref[rb], m1 = X[(0 + rb) * 64], l0 = xhalf_sum(l[rb]), l1 = X[(2 + rb) * 64];
            const float mm = fmaxf(m0, m1), f0 = __builtin_amdgcn_exp2f(m0 - mm), f1 = __builtin_amdgcn_exp2f(m1 - mm);
            const float inv = 1.0f / (l0 * f0 + l1 * f1), c0 = f0 * inv, c1 = f1 * inv;
#pragma unroll
            for (int dh = 0; dh < 2; ++dh)
#pragma unroll
                for (int rq = 0; rq < 4; ++rq) {
                    float v[4];
#pragma unroll
                    for (int e = 0; e < 4; ++e) v[e] = o[rb][dh][4 * rq + e] * c0 + X[(4 + rb * 32 + dh * 16 + 4 * rq + e) * 64] * c1;
                    *(LAS u32x2*)(stg + (32 * rb + r32) * OSTP + (32 * dh + 8 * rq + 4 * hh) * 2) = (u32x2){pk2(v[0], v[1]), pk2(v[2], v[3])};
                }
        }
        asm volatile("s_waitcnt lgkmcnt(0)" ::: "memory");
#pragma unroll
        for (int i = 0; i < 8; ++i) {
            const int row = i * 8 + (lane >> 3), ch = lane & 7;
            const u32x4 ov = *(const LAS u32x4*)(stg + row * OSTP + ch * 16);
            const u32x4 gv = *(const GAS u32x4*)(U.g + (size_t)row * U.opitch + ch * 8);
            u32x4 r;
            r.x = pk2(bflo(ov.x) * bflo(gv.x), bfhi(ov.x) * bfhi(gv.x)); r.y = pk2(bflo(ov.y) * bflo(gv.y), bfhi(ov.y) * bfhi(gv.y));
            r.z = pk2(bflo(ov.z) * bflo(gv.z), bfhi(ov.z) * bfhi(gv.z)); r.w = pk2(bflo(ov.w) * bflo(gv.w), bfhi(ov.w) * bfhi(gv.w));
            *(GAS u32x4*)(U.o + (size_t)row * U.opitch + ch * 8) = r;
        }
    }
    asm volatile("s_waitcnt lgkmcnt(0)" ::: "memory"); __builtin_amdgcn_s_barrier(); asm volatile("" ::: "memory");
}
__device__ __forceinline__ unsigned unit_ask(GAS unsigned* ctr) { return threadIdx.x == 0 ? __hip_atomic_fetch_add(ctr, 1u, __ATOMIC_RELAXED, __HIP_MEMORY_SCOPE_AGENT) : 0u; }
__device__ __forceinline__ int unit_take(LAS unsigned char* lds, unsigned asked) {
    volatile LAS int* sw = (volatile LAS int*)(lds + LDS_SCHED);
    __syncthreads();
    if (threadIdx.x == 0) *sw = (int)asked;
    __syncthreads();
    return __builtin_amdgcn_readfirstlane(*sw);
}
}


#define XB_TMO      128
#define XB_XCNT(j)  (256  + 64 * (j))
#define XB_XSUB(j)  (1280 + 64 * (j))
#define XB_XGEN(j)  (2304 + 64 * (j))
#define XB_TOP      3328
#define XB_TOPGEN   3392
#define XCD_BAR_WORDS 3456
#define XB_SPIN_CAP (1u << 22)
__device__ __forceinline__ unsigned xb_ld(unsigned* p)              { return __hip_atomic_load(p, __ATOMIC_RELAXED, __HIP_MEMORY_SCOPE_AGENT); }
__device__ __forceinline__ unsigned xb_add(unsigned* p, unsigned v) { return __hip_atomic_fetch_add(p, v, __ATOMIC_RELAXED, __HIP_MEMORY_SCOPE_AGENT); }
__device__ __forceinline__ unsigned xb_xcc_id() { return (unsigned)__builtin_amdgcn_s_getreg((3 << 11) | 20) & 0xFu; }
#define XB_SPIN(cond, bar) do { unsigned _sp = 0; while (cond) { __builtin_amdgcn_s_sleep(1); \
    if ((++_sp & 255u) == 0u) { if (xb_ld(&(bar)[XB_TMO])) break; if (_sp > XB_SPIN_CAP) { atomicAdd(&(bar)[XB_TMO], 1u); break; } } } } while (0)
struct XcdBarrier { unsigned* bar; unsigned x; volatile LAS unsigned* st; };
__device__ __forceinline__ XcdBarrier xcd_barrier_post(unsigned* bar, volatile LAS unsigned* st) {
    XcdBarrier b; b.bar = bar; b.x = xb_xcc_id(); b.st = st;
    if (threadIdx.x == 0) (void)xb_add(&bar[XB_XCNT(b.x)], 1u);
    return b;
}
__device__ __forceinline__ void xcd_barrier_complete(unsigned* bar, unsigned x, unsigned& nloc, unsigned& nx) {
    const unsigned G = gridDim.x * gridDim.y * gridDim.z;
    unsigned sum, cnt, mine, sp = 0u;
    for (;;) {
        sum = 0u; cnt = 0u; mine = 0u;
#pragma unroll
        for (unsigned j = 0; j < 16; ++j) { const unsigned c = xb_ld(&bar[XB_XCNT(j)]); sum += c; cnt += (c > 0u) ? 1u : 0u; mine = (j == x) ? c : mine; }
        if (sum == G) break;
        __builtin_amdgcn_s_sleep(1);
        if ((++sp & 255u) == 0u) { if (xb_ld(&bar[XB_TMO])) break; if (sp > XB_SPIN_CAP) { atomicAdd(&bar[XB_TMO], 1u); break; } }
    }
    nloc = mine > 0u ? mine : 1u; nx = cnt > 0u ? cnt : 1u;
}
__device__ __forceinline__ void xcd_barrier(const XcdBarrier& b) {
    asm volatile("s_waitcnt vmcnt(0)" ::: "memory");
    __syncthreads();
    if (threadIdx.x == 0) {
        unsigned* bar = b.bar;
        __builtin_amdgcn_s_waitcnt(0);
        unsigned nloc = b.st[0], nx = b.st[1];
        if (nloc == 0u) { xcd_barrier_complete(bar, b.x, nloc, nx); b.st[0] = nloc; b.st[1] = nx; }
        const unsigned old = xb_add(&bar[XB_XSUB(b.x)], 1u);
        const unsigned gen = old / nloc;
        if (old + 1u == (gen + 1u) * nloc) {
            __builtin_amdgcn_fence(__ATOMIC_RELEASE, "agent");
            asm volatile("s_waitcnt vmcnt(0)" ::: "memory");
            const unsigned og = xb_add(&bar[XB_TOP], 1u);
            const unsigned tg = og / nx;
            if (og + 1u == (tg + 1u) * nx) xb_add(&bar[XB_TOPGEN], 1u);
            else XB_SPIN(xb_ld(&bar[XB_TOPGEN]) == tg, bar);
            __builtin_amdgcn_fence(__ATOMIC_ACQUIRE, "agent");
            xb_add(&bar[XB_XGEN(b.x)], 1u);
            asm volatile("s_waitcnt vmcnt(0)" ::: "memory");
        } else {
            XB_SPIN(xb_ld(&bar[XB_XGEN(b.x)]) == gen, bar);
            __builtin_amdgcn_fence(__ATOMIC_ACQUIRE, "agent");
            asm volatile("s_waitcnt vmcnt(0)" ::: "memory");
        }
    }
    __syncthreads();
}

struct Args { const float* in[22]; float* out; unsigned char* ws; int ph_lo, ph_hi; };
enum { I_XP = 0, I_XS, I_CA_CKV, I_CA_KR, I_CB_K, I_CB_V, I_CC_K, I_CC_V, I_AB_PRE, I_AB_POST, I_AB_WIN, I_AB_QN, I_AB_KVN, I_AB_WUQ, I_AB_WUKV, I_AB_REL, I_AB_WOUT,
       I_C_PRE, I_C_POST, I_C_WIN, I_C_SINKS, I_C_WOUT };

__device__ __forceinline__ void transpose_item(const GAS float* W, int K, int N, GAS bf16_t* WT, LAS float* scr, int item, int lane, int shift_nb = 1 << 30) {
    const int nblk = N / 32, kb = item / nblk, nb = item % nblk, k0 = 64 * kb, n0 = 32 * nb, rsh = nb >= shift_nb ? 32 : 0;
#pragma unroll 8
    for (int i = 0; i < 32; ++i) { const int kk = 2 * i + (lane >> 5); scr[kk * 33 + (lane & 31)] = __builtin_nontemporal_load(W + (size_t)(k0 + kk) * N + n0 + (lane & 31)); }
    asm volatile("s_waitcnt lgkmcnt(0)" ::: "memory");
    const int c = lane & 7;
#pragma unroll
    for (int j = 0; j < 4; ++j) { const int n = (lane >> 3) + 8 * j; const LAS float* s = scr + (8 * c) * 33 + n;
        u32x4 o; o.x = pk2(s[0 * 33], s[1 * 33]); o.y = pk2(s[2 * 33], s[3 * 33]); o.z = pk2(s[4 * 33], s[5 * 33]); o.w = pk2(s[6 * 33], s[7 * 33]);
        *(GAS u32x4*)(WT + (size_t)(rsh + n0 + n) * K + k0 + 8 * c) = o; }
    asm volatile("s_waitcnt lgkmcnt(0)" ::: "memory");
}
__device__ __forceinline__ void rms_row_to_bf16(const GAS float* xrow, const GAS float* gain, GAS bf16_t* orow, int lane) {
    const GAS f32x4* xr = (const GAS f32x4*)xrow + lane; const GAS f32x4* gr = (const GAS f32x4*)gain + lane;
    f32x4 v[4]; float s = 0.f;
#pragma unroll
    for (int j = 0; j < 4; ++j) { v[j] = xr[64 * j]; s += (v[j].x * v[j].x + v[j].y * v[j].y) + (v[j].z * v[j].z + v[j].w * v[j].w); }
    const float rstd = 1.0f / sqrtf(wave_sum(s) * (1.f / DM) + RMS_EPS);
    GAS u32x2* o8 = (GAS u32x2*)orow + lane;
#pragma unroll
    for (int j = 0; j < 4; ++j) { const f32x4 g = gr[64 * j]; u32x2 w; w.x = pk2(v[j].x * rstd * g.x, v[j].y * rstd * g.y); w.y = pk2(v[j].z * rstd * g.z, v[j].w * rstd * g.w); o8[64 * j] = w; }
}

__global__ void __launch_bounds__(512, 2) mega_fwd(Args a) {
    extern __shared__ __attribute__((aligned(16))) unsigned char lds_raw[];
    LAS unsigned char* lds = (LAS unsigned char*)lds_raw;
    cg::grid_group grid = cg::this_grid();
#define GIN(k) ((const GAS float*)a.in[k])
    const int G = gridDim.x, bx = blockIdx.x;
    constexpr int LDS_XB = 132 * 1024;
    if (threadIdx.x < 2) ((volatile LAS unsigned*)(lds + LDS_XB))[threadIdx.x] = 0u;
    __syncthreads();
    const XcdBarrier xbar = xcd_barrier_post((unsigned*)(a.ws + WS_CTL) + 1024, (volatile LAS unsigned*)(lds + LDS_XB));
#define PHASE_PTRS \
    int tid = threadIdx.x; asm volatile("" : "+v"(tid)); const int lane = tid & 63, wave = __builtin_amdgcn_readfirstlane(tid >> 6); (void)lane;   \
    const int gw = bx * 8 + wave, NGW = G * 8; (void)gw; (void)NGW; \
    const size_t gt = (size_t)bx * 512 + tid, NGT = (size_t)G * 512; (void)gt; (void)NGT; \
    GAS unsigned char* ws = (GAS unsigned char*)a.ws; GAS float* dout = (GAS float*)a.out; asm volatile("" : "+s"(ws), "+s"(dout));   \
    GAS unsigned* ctl = (GAS unsigned*)(ws + WS_CTL); (void)ctl; \
    GAS f32x2* ropeA = (GAS f32x2*)(ws + WS_ROPEA); GAS f32x2* ropeC = (GAS f32x2*)(ws + WS_ROPEC); (void)ropeA; (void)ropeC; \
    GAS bf16_t* WIN0 = (GAS bf16_t*)(ws + WS_WIN0); GAS bf16_t* WUQ = (GAS bf16_t*)(ws + WS_WUQ); GAS bf16_t* WUKV = (GAS bf16_t*)(ws + WS_WUKV); (void)WIN0; (void)WUQ; (void)WUKV; \
    GAS bf16_t* WOUT0 = (GAS bf16_t*)(ws + WS_WOUT0); GAS bf16_t* WIN1 = (GAS bf16_t*)(ws + WS_WIN1); GAS bf16_t* WOUT1 = (GAS bf16_t*)(ws + WS_WOUT1); (void)WOUT0; (void)WIN1; (void)WOUT1; \
    GAS bf16_t* KCS = (GAS bf16_t*)(ws + WS_KCS); GAS bf16_t* VCS = (GAS bf16_t*)(ws + WS_VCS); (void)KCS; (void)VCS; \
    GAS bf16_t* Z = (GAS bf16_t*)(ws + WS_Z); GAS bf16_t* KVB = (GAS bf16_t*)(ws + WS_KVB); GAS bf16_t* CACHEC = (GAS bf16_t*)(ws + WS_CACHEC); GAS bf16_t* KRC = (GAS bf16_t*)(ws + WS_KRC); (void)Z; (void)KVB; (void)CACHEC; (void)KRC; \
    GAS bf16_t* KBS = (GAS bf16_t*)(ws + WS_KBS); GAS bf16_t* VBS = (GAS bf16_t*)(ws + WS_VBS); (void)KBS; (void)VBS; \
    GAS bf16_t* Y = (GAS bf16_t*)(ws + WS_Y); GAS bf16_t* H1 = (GAS bf16_t*)(ws + WS_H1); (void)H1; GAS float* YP = (GAS float*)(ws + WS_YP); (void)YP; GAS bf16_t* XN1 = (GAS bf16_t*)(ws + WS_XN1); (void)Y; (void)XN1; \
    GAS bf16_t* XN0 = (GAS bf16_t*)((GAS unsigned char*)dout + DO_XN0); GAS bf16_t* QA = (GAS bf16_t*)((GAS unsigned char*)dout + DO_QA); (void)XN0; (void)QA;
    const int lo = a.ph_lo, hi = a.ph_hi;
    if (lo < 0) grid.sync();
#ifdef PROBE_G2
#define PROBE_GEMM_REP for (int rep_ = 0; rep_ < (a.ph_hi > 5 ? 2 : 1); ++rep_)
#else
#define PROBE_GEMM_REP
#endif
#ifdef PROBE_SYNC
#define EXTRA_SYNC() do { if (a.ph_hi > 5) xcd_barrier(xbar); } while (0)
#else
#define EXTRA_SYNC() do {} while (0)
#endif
#define IN(k) (lo <= (k) && (k) < hi)
#define SEAM(k) do { if (IN(k) && IN((k) + 1)) { xcd_barrier(xbar); EXTRA_SYNC(); } } while (0)

    if (IN(0)) {
        PHASE_PTRS
        LAS float* scr = (LAS float*)(lds + wave * 16384);
        constexpr int I0 = 16 * 101, I1 = 6 * 24, I2 = 4 * 32, I3 = 16 * 32, I4 = 16 * 72, I5 = 16 * 32;
        for (int it = gw; it < I0 + I1 + I2 + I3; it += NGW) {
            int r = it;
            if (r < I0) { transpose_item(GIN(I_AB_WIN), 1024, 3232, WIN0, scr, r, lane, 21); continue; } r -= I0;
            if (r < I1) { transpose_item(GIN(I_AB_WUQ), 384, 768, WUQ, scr, r, lane); continue; } r -= I1;
            if (r < I2) { transpose_item(GIN(I_AB_WUKV), 256, 1024, WUKV, scr, r, lane); continue; } r -= I2;
            transpose_item(GIN(I_AB_WOUT), 1024, 1024, WOUT0, scr, r, lane);
        }
        for (size_t i = gt; i < (size_t)96 * 1024 / 8; i += NGT) { const size_t rr = i >> 7; ((GAS u32x4*)(WIN0 + (size_t)(rr < 32 ? 672 + rr : 3264 + (rr - 32)) * 1024))[i & 127] = (u32x4){0u, 0u, 0u, 0u}; }
        for (size_t i = gt; i < (size_t)8192 * 16; i += NGT) {
            const int pos = (int)(i >> 4), j = (int)(i & 15);
            const float inv = exp2f(-(float)j * 1.18322304f);
            const float ang = (float)pos * inv;
            const f32x2 cs = {cosf(ang), sinf(ang)};
            ropeA[i] = cs; if ((j & 1) == 0) ropeC[(size_t)pos * 8 + (j >> 1)] = cs;
        }
        {
            f32x4 nx[4];
#define P0_LOAD(r) do { const GAS f32x4* xr_ = (const GAS f32x4*)((r) < MP ? GIN(I_XP) + (size_t)(r) * DM : GIN(I_XS) + (size_t)((r) - MP) * DM) + lane; \
                _Pragma("unroll") for (int j = 0; j < 4; ++j) nx[j] = __builtin_nontemporal_load(xr_ + 64 * j); } while (0)
            const GAS f32x4* gr = (const GAS f32x4*)GIN(I_AB_PRE) + lane;
            if (gw < MT) P0_LOAD(gw);
            for (int r = gw; r < MT; r += NGW) {
                f32x4 v[4]; float sq = 0.f;
#pragma unroll
                for (int j = 0; j < 4; ++j) { v[j] = nx[j]; sq += (v[j].x * v[j].x + v[j].y * v[j].y) + (v[j].z * v[j].z + v[j].w * v[j].w); }
                if (r + NGW < MT) P0_LOAD(r + NGW);
                const float rstd = 1.0f / sqrtf(wave_sum(sq) * (1.f / DM) + RMS_EPS);
                GAS u32x2* o8 = (GAS u32x2*)(XN0 + (size_t)r * DM) + lane;
#pragma unroll
                for (int j = 0; j < 4; ++j) { const f32x4 g = gr[64 * j]; o8[64 * j] = (u32x2){pk2(v[j].x * rstd * g.x, v[j].y * rstd * g.y), pk2(v[j].z * rstd * g.z, v[j].w * rstd * g.w)}; }
            }
#undef P0_LOAD
        }
        for (size_t i = gt; i < (size_t)8 * 4096 * 256 / 4; i += NGT) { const f32x4 v = __builtin_nontemporal_load((const GAS f32x4*)GIN(I_CA_CKV) + i); ((GAS u32x2*)CACHEC)[i] = (u32x2){pk2(v.x, v.y), pk2(v.z, v.w)}; }
    }
    SEAM(0);

    if (IN(1)) {
        PHASE_PTRS
        pg8::Gemm g{XN0, WIN0, MT, ZP, 1024, 1024, 1024}; pg8::StaticOrder S; S.init(MT, ZP, G, bx);
        pg8::EpiStrip<0> E{Z, ZP, (const GAS f32x4*)ropeA, (const GAS f32x4*)ropeC, dout, KCS, VCS};
        PROBE_GEMM_REP pg8::gemm_phase<pg8::EpiStrip<0>, true>(lds, g, S, E);
        const int nlate = 858 - 3 * G;
        if (nlate > 0 && nlate < G) {
            pg8::Gemm g2{CACHEC, WUKV, 32768, 1024, 256, 256, 256}; pg8::StaticOrder S2; S2.init(32768, 1024, G - nlate, bx - nlate);
            if (bx < nlate) S2.init_one(-2, 0);
            pg8::EpiStrip<2> E2{KVB + (size_t)MT * 1024, 1024, (const GAS f32x4*)ropeA, (const GAS f32x4*)ropeC, dout, KCS, VCS};
            pg8::gemm_phase<pg8::EpiStrip<2>, true>(lds, g2, S2, E2);
        }
    }
    SEAM(1);

    if (IN(2)) {
        PHASE_PTRS
        for (size_t i = gt; i < (size_t)8 * 4096 * 32 / 4; i += NGT) { const f32x4 v = __builtin_nontemporal_load((const GAS f32x4*)GIN(I_CA_KR) + i); ((GAS u32x2*)KRC)[i] = (u32x2){pk2(v.x, v.y), pk2(v.z, v.w)}; }
        for (size_t i = gt; i < (size_t)2 * 8 * 512 * 512 / 4; i += NGT) {
            const int which = (int)(i / (8 * 512 * 512 / 4)); const size_t e = (i % (8 * 512 * 512 / 4)) * 4; const int b = (int)(e >> 18), t = (int)((e >> 9) & 511), c = (int)(e & 511);
            const f32x4 v = __builtin_nontemporal_load((const GAS f32x4*)((const GAS float*)a.in[which ? I_CB_V : I_CB_K] + e));
            *(GAS u32x2*)((which ? VBS : KBS) + ((size_t)b * 576 + t) * 512 + c) = (u32x2){pk2(v.x, v.y), pk2(v.z, v.w)};
            if (t >= 64) __builtin_nontemporal_store(v, (GAS f32x4*)(dout + (which ? O_BV_S : O_BK_S) + ((size_t)b * 512 + t - 64) * 512 + c));
        }
        for (size_t i = gt; i < (size_t)2 * 8 * 128 * 128 / 4; i += NGT) {
            const int which = (int)(i / (8 * 128 * 128 / 4)); const size_t e = (i % (8 * 128 * 128 / 4)) * 4; const int b = (int)(e >> 14), t = (int)((e >> 7) & 127), c = (int)(e & 127);
            const f32x4 v = __builtin_nontemporal_load((const GAS f32x4*)((const GAS float*)a.in[which ? I_CC_V : I_CC_K] + e));
            *(GAS u32x2*)((which ? VCS : KCS) + ((size_t)b * 192 + t) * 128 + c) = (u32x2){pk2(v.x, v.y), pk2(v.z, v.w)};
            if (t >= 64) __builtin_nontemporal_store(v, (GAS f32x4*)(dout + (which ? O_CV_S : O_CK_S) + ((size_t)b * 128 + t - 64) * 128 + c));
        }
        unsigned nq[3], mq[3]; u32x2 nc, mc; unsigned nk, mk;
#define P2_LOAD(r, nq, nc, nk) do { const GAS bf16_t* z_ = Z + (size_t)(r) * ZP; _Pragma("unroll") for (int j = 0; j < 3; ++j) nq[j] = *(const GAS unsigned*)(z_ + 2 * lane + 128 * j); \
            nc = *(const GAS u32x2*)(z_ + ZC_CKV + 4 * lane); nk = *(const GAS unsigned*)(z_ + ZC_KR + 2 * (lane & 15)); } while (0)
        if (gw < MT) P2_LOAD(gw, nq, nc, nk);
        if (gw + NGW < MT) P2_LOAD(gw + NGW, mq, mc, mk);
        for (int r = gw; r < MT; r += NGW) {
            GAS bf16_t* zr = Z + (size_t)r * ZP;
            const bool smp = r >= MP; const int b = smp ? (r - MP) >> 6 : r >> 13, t = smp ? (r - MP) & 63 : r & 8191;
            unsigned wv[3]; const u32x2 wc2 = nc; const unsigned wk = nk;
#pragma unroll
            for (int j = 0; j < 3; ++j) wv[j] = nq[j];
#pragma unroll
            for (int j = 0; j < 3; ++j) nq[j] = mq[j];
            nc = mc; nk = mk;
            if (r + 2 * NGW < MT) P2_LOAD(r + 2 * NGW, mq, mc, mk);
            {
                float s = 0.f;
#pragma unroll
                for (int j = 0; j < 3; ++j) { const float x0 = bflo(wv[j]), x1 = bfhi(wv[j]); s += x0 * x0 + x1 * x1; }
                const float rstd = 1.0f / sqrtf(wave_sum(s) * (1.f / 384.f) + RMS_EPS);
#pragma unroll
                for (int j = 0; j < 3; ++j) { const f32x2 gq = *(const GAS f32x2*)(GIN(I_AB_QN) + 2 * lane + 128 * j);
                    *(GAS unsigned*)(zr + 2 * lane + 128 * j) = pk2(bflo(wv[j]) * rstd * gq.x, bfhi(wv[j]) * rstd * gq.y); }
            }
            {
                const u32x2 wv2 = wc2;
                const float x0 = bflo(wv2.x), x1 = bfhi(wv2.x), x2 = bflo(wv2.y), x3 = bfhi(wv2.y);
                const float rstd = 1.0f / sqrtf(wave_sum(x0 * x0 + x1 * x1 + x2 * x2 + x3 * x3) * (1.f / 256.f) + RMS_EPS);
                const f32x4 gk = *(const GAS f32x4*)(GIN(I_AB_KVN) + 4 * lane);
                const f32x4 c = {x0 * rstd * gk.x, x1 * rstd * gk.y, x2 * rstd * gk.z, x3 * rstd * gk.w};
                *(GAS u32x2*)(zr + ZC_CKV + 4 * lane) = (u32x2){pk2(c.x, c.y), pk2(c.z, c.w)};
                __builtin_nontemporal_store(c, (GAS f32x4*)(dout + (smp ? O_CKV_S + (size_t)(r - MP) * 256 : O_CKV_P + (size_t)r * 256) + 4 * lane));
            }
            if (lane < 16) {
                *(GAS f32x2*)(dout + (smp ? O_KR_S + (size_t)(r - MP) * 32 : O_KR_P + (size_t)r * 32) + 2 * lane) = (f32x2){bflo(wk), bfhi(wk)};
            }
            if (smp || t >= 7680) {
                const u32x4 kv = *(const GAS u32x4*)(zr + ZC_KB + 8 * lane), vv = *(const GAS u32x4*)(zr + ZC_VB + 8 * lane);
                GAS float* kd = dout + (smp ? O_BK_S + ((size_t)b * 512 + 448 + t) * 512 : O_BK_P + ((size_t)b * 512 + (t - 7680)) * 512) + 8 * lane;
                GAS float* vd = dout + (smp ? O_BV_S + ((size_t)b * 512 + 448 + t) * 512 : O_BV_P + ((size_t)b * 512 + (t - 7680)) * 512) + 8 * lane;
                *(GAS f32x4*)kd = (f32x4){bflo(kv.x), bfhi(kv.x), bflo(kv.y), bfhi(kv.y)}; *(GAS f32x4*)(kd + 4) = (f32x4){bflo(kv.z), bfhi(kv.z), bflo(kv.w), bfhi(kv.w)};
                *(GAS f32x4*)vd = (f32x4){bflo(vv.x), bfhi(vv.x), bflo(vv.y), bfhi(vv.y)}; *(GAS f32x4*)(vd + 4) = (f32x4){bflo(vv.z), bfhi(vv.z), bflo(vv.w), bfhi(vv.w)};
                if (smp) { *(GAS u32x4*)(KBS + ((size_t)b * 576 + 512 + t) * 512 + 8 * lane) = kv; *(GAS u32x4*)(VBS + ((size_t)b * 576 + 512 + t) * 512 + 8 * lane) = vv; }
            }
        }
    }
#undef P2_LOAD
    SEAM(2);

    if (IN(3)) {
        PHASE_PTRS
        { pg8::Gemm g{Z, WUQ, MT, 768, 384, ZP, 384}; pg8::StaticOrder S; S.init(MT, 768, G, bx);
          pg8::EpiStrip<1> E{QA, 768, (const GAS f32x4*)ropeA, (const GAS f32x4*)ropeC, dout, KCS, VCS};
          PROBE_GEMM_REP pg8::gemm_phase<pg8::EpiStrip<1>, true>(lds, g, S, E); }
        { pg8::Gemm g{Z + ZC_CKV, WUKV, MT, 1024, 256, ZP, 256}; pg8::StaticOrder S; S.init(MT, 1024, G, (bx + (G > 198 ? G - 198 : 0)) % G);
          pg8::EpiStrip<2> E{KVB, 1024, (const GAS f32x4*)ropeA, (const GAS f32x4*)ropeC, dout, KCS, VCS};
          PROBE_GEMM_REP pg8::gemm_phase<pg8::EpiStrip<2>, true>(lds, g, S, E); }
        if (!(858 - 3 * G > 0 && 858 - 3 * G < G))
        { pg8::Gemm g{CACHEC, WUKV, 32768, 1024, 256, 256, 256}; pg8::StaticOrder S; S.init(32768, 1024, G, (bx + 206) % G);
          pg8::EpiStrip<2> E{KVB + (size_t)MT * 1024, 1024, (const GAS f32x4*)ropeA, (const GAS f32x4*)ropeC, dout, KCS, VCS};
          PROBE_GEMM_REP pg8::gemm_phase<pg8::EpiStrip<2>, true>(lds, g, S, E); }
    }
    SEAM(3);

    if (IN(4)) {
        PHASE_PTRS
        const int probe_pass = 0;
        for (;;) {
            const int uq = att::unit_take(lds, att::unit_ask(ctl + 0));
            if (uq >= 576) break;
            const int u = uq < 64 ? 512 + uq : uq - 64;
            att::AUnit U; U.qpitch = 768; U.opitch = ZP; U.kpitch = 1024; U.qpos0 = 0; U.wchunk = 0; U.sink = 0.f; U.nostore = probe_pass;
            if (u < 512) {
                const int qb = 31 - (u >> 4), b = (u >> 3) & 1, h = u & 7; const size_t r0 = (size_t)b * 8192;
                U.t_lo = 0; U.t_hi = 4 * qb + 3; U.t_split = 1 << 30;
                U.k1 = KVB + r0 * 1024 + h * 128; U.v1 = U.k1 + 64; U.kr1 = Z + r0 * ZP + ZC_KR; U.krpitch1 = ZP;
                U.k2 = U.k1; U.v2 = U.v1; U.kr2 = U.kr1; U.krpitch2 = ZP;
                U.wactive = true; U.wt_lo = 0; U.wt_hi = 4 * qb + (wave & 3);
                const size_t qrow = r0 + 256 * qb + 64 * (wave & 3);
                U.q = QA + qrow * 768 + h * 96; U.o = Z + qrow * ZP + ZC_GA + h * 64; U.g = U.o;
            } else {
                const int v = u - 512, b = v >> 3, h = v & 7;
                U.t_lo = 0; U.t_hi = 64; U.t_split = 64;
                U.k1 = KVB + ((size_t)MT + (size_t)b * 4096) * 1024 + h * 128; U.v1 = U.k1 + 64; U.kr1 = KRC + (size_t)b * 4096 * 32; U.krpitch1 = 32;
                const size_t nrow = (size_t)MP + b * 64;
                U.k2 = KVB + nrow * 1024 + h * 128; U.v2 = U.k2 + 64; U.kr2 = Z + nrow * ZP + ZC_KR; U.krpitch2 = ZP;
                U.wactive = (wave & 3) == 0; U.wt_lo = 0; U.wt_hi = 64;
                const size_t qrow = nrow;
                U.q = QA + qrow * 768 + h * 96; U.o = Z + qrow * ZP + ZC_GA + h * 64; U.g = U.o;
            }
            att::attn_unit_mla(lds, U);
        }
        for (;;) {
            const int u = att::unit_take(lds, att::unit_ask(ctl + 64));
            if (u >= 576) break;
            att::AUnit U; U.qpitch = ZP; U.opitch = ZP; U.t_split = 1 << 30; U.sink = 0.f; U.krpitch1 = 0; U.krpitch2 = 0; U.nostore = 0;
            int h;
            if (u < 512) {
                const int qb = 31 - (u >> 4), b = (u >> 3) & 1; h = u & 7; const size_t r0 = (size_t)b * 8192;
                const int cq = 4 * qb + (wave >> 1);
                U.t_lo = max(0, 4 * qb - 8); U.t_hi = 4 * qb + 3; U.kpitch = ZP;
                U.k1 = Z + r0 * ZP + ZC_KB + h * 64; U.v1 = Z + r0 * ZP + ZC_VB + h * 64;
                U.wactive = true; U.wt_lo = max(0, cq - 8); U.wt_hi = cq; U.wchunk = cq; U.qpos0 = 64 * cq + 32 * (wave & 1);
                const size_t qrow = r0 + 256 * qb + 32 * wave;
                U.q = Z + qrow * ZP + ZC_QB + h * 64; U.o = (GAS bf16_t*)U.q; U.g = Z + qrow * ZP + ZC_GB + h * 64;
            } else {
                const int v = u - 512, b = v >> 3; h = v & 7;
                U.t_lo = 0; U.t_hi = 8; U.kpitch = 512;
                U.k1 = KBS + (size_t)b * 576 * 512 + h * 64; U.v1 = VBS + (size_t)b * 576 * 512 + h * 64;
                U.wactive = wave < 2; U.wt_lo = 0; U.wt_hi = 8; U.wchunk = 8; U.qpos0 = 512 + 32 * (wave & 1);
                const size_t qrow = (size_t)MP + b * 64 + 32 * (wave & 1);
                U.q = Z + qrow * ZP + ZC_QB + h * 64; U.o = (GAS bf16_t*)U.q; U.g = Z + qrow * ZP + ZC_GB + h * 64;
            }
            U.k2 = U.k1; U.v2 = U.v1; U.kr1 = U.k1; U.kr2 = U.k1;
            if (tid < 257) ((LAS float*)(lds + att::LDS_BIAS))[tid] = GIN(I_AB_REL)[h * 257 + tid] * LOG2E;
            att::attn_unit<1>(lds, U);
        }
    }
    SEAM(4);

    if (IN(5)) {
        PHASE_PTRS
        { pg8::Gemm g{Z + ZC_GA, WOUT0, MP, 1024, 1024, ZP, 1024}; pg8::StaticOrder S; S.init(MP, 1024, G, bx);
          pg8::EpiStrip<2> E{Y, 1024, (const GAS f32x4*)ropeA, (const GAS f32x4*)ropeC, dout, KCS, VCS};
          PROBE_GEMM_REP pg8::gemm_phase<pg8::EpiStrip<2>, true>(lds, g, S, E); }
        { const int kq = bx & 3, un = (bx >> 2) & 7;
          pg8::Gemm g{Z + ZC_GA + kq * 256, WOUT0 + kq * 256, MT, 1024, 256, ZP, 1024}; pg8::StaticOrder S; S.init_one(bx < 32 ? 64 + (un >> 2) : -2, un & 3);
          pg8::EpiF32 E{YP + (size_t)kq * 524288 - (size_t)MP * 1024, 1024};
          pg8::gemm_phase<pg8::EpiF32, true>(lds, g, S, E); }
        {
            constexpr int J4 = 16 * 72, J5 = 16 * 32;
            LAS float* scr = (LAS float*)(lds + wave * 16384);
            const int nwv = (G > 32 ? G - 32 : G) * 8, wv0 = (G > 32 ? bx - 32 : bx) * 8 + wave;
            if (wv0 >= 0) for (int it = wv0; it < J4 + J5; it += nwv) {
                if (it < J4) transpose_item(GIN(I_C_WIN), 1024, 2304, WIN1, scr, it, lane); else transpose_item(GIN(I_C_WOUT), 1024, 1024, WOUT1, scr, it - J4, lane); }
        }
    }
    SEAM(5);

#ifdef PROBE_R2
    for (int rr_ = 0; rr_ < (a.ph_hi > 5 ? 2 : 1); ++rr_)
#endif
    if (IN(6)) {
        PHASE_PTRS
        const GAS f32x4* pg = (const GAS f32x4*)GIN(I_AB_POST) + lane; const GAS f32x4* ng = (const GAS f32x4*)GIN(I_C_PRE) + lane;
        u32x2 ny[4]; f32x4 nx[4];
#define P6_LOAD(r) do { const GAS f32x4* xr_ = (const GAS f32x4*)((r) < MP ? GIN(I_XP) + (size_t)(r) * DM : GIN(I_XS) + (size_t)((r) - MP) * DM) + lane; \
            _Pragma("unroll") for (int j = 0; j < 4; ++j) nx[j] = __builtin_nontemporal_load(xr_ + 64 * j); \
            if ((r) < MP) { const GAS u32x2* yr_ = (const GAS u32x2*)(Y + (size_t)(r) * DM) + lane; _Pragma("unroll") for (int j = 0; j < 4; ++j) ny[j] = __builtin_nontemporal_load(yr_ + 64 * j); } \
            else { const GAS f32x4* pr_ = (const GAS f32x4*)(YP + (size_t)((r) - MP) * DM) + lane;     \
                _Pragma("unroll") for (int j = 0; j < 4; ++j) { const f32x4 t_ = (pr_[64 * j] + pr_[64 * j + 131072]) + (pr_[64 * j + 262144] + pr_[64 * j + 393216]); ny[j] = (u32x2){pk2(t_.x, t_.y), pk2(t_.z, t_.w)}; } } } while (0)
        if (gw < MT) P6_LOAD(gw);
        for (int r = gw; r < MT; r += NGW) {
            f32x4 v[4], x[4]; float s = 0.f;
#pragma unroll
            for (int j = 0; j < 4; ++j) { v[j] = (f32x4){bflo(ny[j].x), bfhi(ny[j].x), bflo(ny[j].y), bfhi(ny[j].y)}; x[j] = nx[j]; s += (v[j].x * v[j].x + v[j].y * v[j].y) + (v[j].z * v[j].z + v[j].w * v[j].w); }
            if (r + NGW < MT) P6_LOAD(r + NGW);
            const float rstd = 1.0f / sqrtf(wave_sum(s) * (1.f / DM) + RMS_EPS);
            float s2 = 0.f;
#pragma unroll
            for (int j = 0; j < 4; ++j) { v[j] = x[j] + v[j] * rstd * pg[64 * j]; s2 += (v[j].x * v[j].x + v[j].y * v[j].y) + (v[j].z * v[j].z + v[j].w * v[j].w); }
            const float rstd2 = 1.0f / sqrtf(wave_sum(s2) * (1.f / DM) + RMS_EPS);
            GAS u32x2* hr = (GAS u32x2*)(H1 + (size_t)r * DM) + lane; GAS u32x2* o8 = (GAS u32x2*)(XN1 + (size_t)r * DM) + lane;
#pragma unroll
            for (int j = 0; j < 4; ++j) { __builtin_nontemporal_store((u32x2){pk2(v[j].x, v[j].y), pk2(v[j].z, v[j].w)}, hr + 64 * j); const f32x4 g = ng[64 * j];
                o8[64 * j] = (u32x2){pk2(v[j].x * rstd2 * g.x, v[j].y * rstd2 * g.y), pk2(v[j].z * rstd2 * g.z, v[j].w * rstd2 * g.w)}; }
        }
#undef P6_LOAD
    }
    SEAM(6);

    if (IN(7)) {
        PHASE_PTRS
        pg8::Gemm g{XN1, WIN1, MT, Z1P, 1024, 1024, 1024}; pg8::StaticOrder S; S.init(MT, Z1P, G, bx);
        pg8::EpiStrip<3> E{Z, Z1P, (const GAS f32x4*)ropeA, (const GAS f32x4*)ropeC, dout, KCS, VCS};
        PROBE_GEMM_REP pg8::gemm_phase<pg8::EpiStrip<3>, true>(lds, g, S, E);
    }
    SEAM(7);

    if (IN(8)) {
        PHASE_PTRS
        for (int u = bx; u < 1056; u += G) {
            att::AUnit U; U.qpitch = Z1P; U.opitch = Z1P; U.t_split = 1 << 30; U.krpitch1 = 0; U.krpitch2 = 0; U.qpos0 = 0; U.wchunk = 0; U.nostore = 0;
            int qh; size_t qrow;
            if (u < 1024) {
                const int half = u & 1, hk = (u >> 1) & 1, b = (u >> 2) & 1, c = 127 - (u >> 3); const size_t r0 = (size_t)b * 8192;
                U.t_lo = max(0, c - 2); U.t_hi = c; U.kpitch = Z1P;
                U.k1 = Z + r0 * Z1P + Z1_K + hk * 64; U.v1 = Z + r0 * Z1P + Z1_V + hk * 64;
                qh = hk * 8 + half * 4 + (wave >> 1); qrow = r0 + 64 * c + 32 * (wave & 1);
            } else {
                const int v = u - 1024, half = v & 1, hk = (v >> 1) & 1, b = v >> 2;
                U.t_lo = 0; U.t_hi = 2; U.kpitch = 128;
                U.k1 = KCS + (size_t)b * 192 * 128 + hk * 64; U.v1 = VCS + (size_t)b * 192 * 128 + hk * 64;
                qh = hk * 8 + half * 4 + (wave >> 1); qrow = (size_t)MP + b * 64 + 32 * (wave & 1);
            }
            U.wactive = true; U.wt_lo = U.t_lo; U.wt_hi = U.t_hi;
            U.k2 = U.k1; U.v2 = U.v1; U.kr1 = U.k1; U.kr2 = U.k1;
            U.q = Z + qrow * Z1P + qh * 64; U.o = (GAS bf16_t*)U.q; U.g = Z + qrow * Z1P + Z1_G + qh * 64;
            U.sink = GIN(I_C_SINKS)[qh] * LOG2E;
            att::attn_unit<2>(lds, U);
        }
    }
    SEAM(8);

    if (IN(9)) {
        PHASE_PTRS
        { pg8::Gemm g{Z, WOUT1, MP, 1024, 1024, Z1P, 1024}; pg8::StaticOrder S; S.init(MP, 1024, G, bx);
          pg8::EpiStrip<2> E{Y, 1024, (const GAS f32x4*)ropeA, (const GAS f32x4*)ropeC, dout, KCS, VCS};
          PROBE_GEMM_REP pg8::gemm_phase<pg8::EpiStrip<2>, true>(lds, g, S, E); }
        { const int kq = bx & 3, un = (bx >> 2) & 7;
          pg8::Gemm g{Z + kq * 256, WOUT1 + kq * 256, MT, 1024, 256, Z1P, 1024}; pg8::StaticOrder S; S.init_one(bx < 32 ? 64 + (un >> 2) : -2, un & 3);
          pg8::EpiF32 E{YP + (size_t)kq * 524288 - (size_t)MP * 1024, 1024};
          pg8::gemm_phase<pg8::EpiF32, true>(lds, g, S, E); }
    }
    SEAM(9);

    if (IN(10)) {
        PHASE_PTRS
        const GAS f32x4* pg = (const GAS f32x4*)GIN(I_C_POST) + lane;
        u32x2 ny[4]; u32x2 nh[4];
#define P10_LOAD(r) do { const GAS u32x2* hr_ = (const GAS u32x2*)(H1 + (size_t)(r) * DM) + lane; \
            _Pragma("unroll") for (int j = 0; j < 4; ++j) nh[j] = __builtin_nontemporal_load(hr_ + 64 * j); \
            if ((r) < MP) { const GAS u32x2* yr_ = (const GAS u32x2*)(Y + (size_t)(r) * DM) + lane; _Pragma("unroll") for (int j = 0; j < 4; ++j) ny[j] = __builtin_nontemporal_load(yr_ + 64 * j); } \
            else { const GAS f32x4* pr_ = (const GAS f32x4*)(YP + (size_t)((r) - MP) * DM) + lane; \
                _Pragma("unroll") for (int j = 0; j < 4; ++j) { const f32x4 t_ = (pr_[64 * j] + pr_[64 * j + 131072]) + (pr_[64 * j + 262144] + pr_[64 * j + 393216]); ny[j] = (u32x2){pk2(t_.x, t_.y), pk2(t_.z, t_.w)}; } } } while (0)
        if (gw < MT) P10_LOAD(gw);
        for (int r = gw; r < MT; r += NGW) {
            f32x4 v[4], h[4]; float s = 0.f;
#pragma unroll
            for (int j = 0; j < 4; ++j) { v[j] = (f32x4){bflo(ny[j].x), bfhi(ny[j].x), bflo(ny[j].y), bfhi(ny[j].y)}; h[j] = (f32x4){bflo(nh[j].x), bfhi(nh[j].x), bflo(nh[j].y), bfhi(nh[j].y)}; s += (v[j].x * v[j].x + v[j].y * v[j].y) + (v[j].z * v[j].z + v[j].w * v[j].w); }
            if (r + NGW < MT) P10_LOAD(r + NGW);
            const float rstd = 1.0f / sqrtf(wave_sum(s) * (1.f / DM) + RMS_EPS);
            GAS f32x4* hr = (GAS f32x4*)(dout + O_Y + (size_t)r * DM) + lane;
#pragma unroll
            for (int j = 0; j < 4; ++j) __builtin_nontemporal_store(h[j] + v[j] * rstd * pg[64 * j], hr + 64 * j);
        }
#undef P10_LOAD
    }
#undef IN
#undef SEAM
}

extern "C" void kernel_launch(void* const* d_in, const int* in_sizes, int n_in, void* d_out, int out_size, void* d_ws, size_t ws_size, hipStream_t stream) {
    constexpr int LDS_BYTES = 136 * 1024;
    static int grid = 0;
    if (grid == 0) {
        if (n_in != 22 || ws_size < WS_END) { fprintf(stderr, "kernel_launch: unexpected n_in %d / ws_size %zu\n", n_in, ws_size); grid = -1; return; }
        int dev = 0, cus = 0, per_cu = 0;
        (void)hipGetDevice(&dev);
        (void)hipDeviceGetAttribute(&cus, hipDeviceAttributeMultiprocessorCount, dev);
        (void)hipFuncSetAttribute((const void*)mega_fwd, hipFuncAttributeMaxDynamicSharedMemorySize, LDS_BYTES);
        (void)hipOccupancyMaxActiveBlocksPerMultiprocessor(&per_cu, (const void*)mega_fwd, 512, LDS_BYTES);
        if (per_cu < 1) { fprintf(stderr, "kernel_launch: occupancy query says %d blocks per CU\n", per_cu); per_cu = 1; }
        grid = cus * per_cu;
        (void)hipGetLastError();
    }
    if (grid < 0) return;
    (void)hipMemsetAsync((char*)d_ws + WS_CTL, 0, 64 * 1024, stream);
    Args a{};
    for (int i = 0; i < 22; ++i) a.in[i] = (const float*)d_in[i];
    a.out = (float*)d_out; a.ws = (unsigned char*)d_ws; a.ph_lo = 0; a.ph_hi = 11;
    void* args[] = {&a};
    hipError_t e = hipLaunchCooperativeKernel((const void*)mega_fwd, dim3(grid), dim3(512), args, LDS_BYTES, stream);
    if (e != hipSuccess) fprintf(stderr, "kernel_launch: cooperative launch failed: %s (grid %d)\n", hipGetErrorString(e), grid);
}
```

```cpp
#include <hip/hip_runtime.h>
#include <hip/hip_cooperative_groups.h>
#include <cstdio>
#include <cstdint>
#include <cmath>
namespace cg = cooperative_groups;

#define LAS __attribute__((address_space(3)))
#define GAS __attribute__((address_space(1)))
typedef unsigned short bf16_t;
typedef short bf16x8 __attribute__((ext_vector_type(8)));
typedef short s16x4 __attribute__((ext_vector_type(4)));
typedef float f32x4 __attribute__((ext_vector_type(4)));
typedef float f32x2 __attribute__((ext_vector_type(2)));
typedef float f32x16 __attribute__((ext_vector_type(16)));
typedef unsigned u32x4 __attribute__((ext_vector_type(4)));
typedef unsigned u32x2 __attribute__((ext_vector_type(2)));
typedef __bf16 bf16x2_t __attribute__((ext_vector_type(2)));

constexpr int MP = 16384, MS = 512, MT = MP + MS;
constexpr int DM = 1024;
constexpr int ZP = 3328;
constexpr int Z1P = 2304;
constexpr int ZC_CKV = 384, ZC_KR = 640, ZC_GA = 704, ZC_QB = 1216, ZC_KB = 1728, ZC_VB = 2240, ZC_GB = 2752;
constexpr int Z1_K = 1024, Z1_V = 1152, Z1_G = 1280;
constexpr float LOG2E = 1.4426950408889634f;
constexpr float A_SC = 0.10206207261596575f * LOG2E;
constexpr float B_SC = 0.125f * LOG2E;
constexpr float C_SC = 0.125f * LOG2E;
constexpr float RMS_EPS = 1e-6f;
constexpr size_t O_Y = 0, O_CKV_P = 17301504, O_KR_P = 21495808, O_BK_P = 22020096, O_BV_P = 22544384, O_CK_P = 23068672, O_CV_P = 23101440,
                 O_CKV_S = 23134208, O_KR_S = 23265280, O_BK_S = 23281664, O_BV_S = 25378816, O_CK_S = 27475968, O_CV_S = 27607040;
constexpr size_t KiB = 1024, MiB = 1024 * 1024;
constexpr size_t WS_CTL = 0, WS_ROPEA = 64 * KiB, WS_ROPEC = 64 * KiB + 1 * MiB, WS_WIN0 = 2 * MiB, WS_WUQ = 8 * MiB + 512 * KiB, WS_WUKV = 9 * MiB + 256 * KiB,
                 WS_WOUT0 = 10 * MiB, WS_WIN1 = 12 * MiB, WS_WOUT1 = 16 * MiB + 512 * KiB, WS_KCS = 18 * MiB + 512 * KiB, WS_VCS = WS_KCS + 384 * KiB,
                 WS_Z = 20 * MiB, WS_KVB = 128 * MiB, WS_CACHEC = 225 * MiB, WS_KRC = 241 * MiB, WS_KBS = 243 * MiB, WS_VBS = 247 * MiB + 512 * KiB,
                 WS_Y = 128 * MiB, WS_H1 = 161 * MiB  , WS_XN1 = 194 * MiB, WS_YP = 228 * MiB  , WS_END = 252 * MiB;
constexpr size_t DO_XN0 = 0, DO_QA = 34 * MiB;

__device__ __forceinline__ unsigned pk2(float lo, float hi) { f32x2 v = {lo, hi}; bf16x2_t b = __builtin_convertvector(v, bf16x2_t); return __builtin_bit_cast(unsigned, b); }
__device__ __forceinline__ float bflo(unsigned w) { return __uint_as_float(w << 16); }
__device__ __forceinline__ float bfhi(unsigned w) { return __uint_as_float(w & 0xffff0000u); }
__device__ __forceinline__ float wave_sum(float v) {
#pragma unroll
    for (int o = 1; o < 64; o <<= 1) v += __shfl_xor(v, o);
    return v;
}
__device__ __forceinline__ float silu_f(float x) { return x * __builtin_amdgcn_rcpf(1.0f + __builtin_amdgcn_exp2f(-x * LOG2E)); }
__device__ __forceinline__ int row_pos(int row) { return row < MP ? (row & 8191) : 4096 + ((row - MP) & 63); }

namespace pg8 {
constexpr int BM = 256, BK = 64, HALF = 128, HTB = HALF * BK * 2, STAGE_BYTES = 8 * HTB, NXCD = 8, WGM = 8;
__host__ __device__ __forceinline__ int lds_byte(int r, int c) { const int st = (r >> 4) * 2 + (c >> 5), rr = r & 15, cc = c & 31, ob = rr * 64 + cc * 2; return st * 1024 + (ob ^ (((ob >> 9) & 1) << 5)); }
__host__ __device__ __forceinline__ void stage_rc(int b, int& R, int& C) { const int st = b / 1024, sb = b % 1024, swz = sb ^ (((sb >> 9) & 1) << 5); R = (st >> 1) * 16 + swz / 64; C = (st & 1) * 32 + (swz % 64) / 2; }
__host__ __device__ __forceinline__ int perm32(int rho) { const int n = rho >> 4, i = rho & 15; return 8 * (i >> 2) + 4 * n + (i & 3); }
struct Unit { int pm, pn; };
struct Gemm { const GAS bf16_t* A; const GAS bf16_t* Bt; int M, N, K, lda, ldb; };
struct StaticOrder {
    int nM, nN, nwg, G, c, one_pm, one_pn;
    __device__ void init(int M, int N, int G_, int c_) { nM = M / BM; nN = N / BM; nwg = nM * nN; G = G_; c = c_; one_pm = -1; one_pn = 0; }
    __device__ void init_one(int pm, int pn) { nM = nN = nwg = G = 1; c = 0; one_pm = pm; one_pn = pn; }
    __device__ bool next(int i, Unit& u) const {
        if (one_pm != -1) { if (i > 0 || one_pm < 0) return false; u.pm = one_pm; u.pn = one_pn; return true; }
        const long L = (long)i * G + c; if (L >= nwg) return false;
        int wgid = (int)L; { const int q = nwg / NXCD, r = nwg % NXCD, xcd = wgid % NXCD, off = wgid / NXCD; wgid = (xcd < r ? xcd * (q + 1) : r * (q + 1) + (xcd - r) * q) + off; }
        const int nig = WGM * nN, gid = wgid / nig, fm = gid * WGM, gsz = (nM - fm) < WGM ? (nM - fm) : WGM;
        u.pm = fm + ((wgid % nig) % gsz); u.pn = (wgid % nig) / gsz; return true;
    }
};
template <class Epi, bool ALIGN_EPI>
__device__ __forceinline__ void gemm_phase(LAS unsigned char* lds, const Gemm g, const StaticOrder& S, const Epi& E) {
    int tid = threadIdx.x; asm volatile("" : "+v"(tid));
    const int wid = __builtin_amdgcn_readfirstlane(tid >> 6), lane = tid & 63, wr = wid >> 2, wc = wid & 3, fr = lane & 15, fq = lane >> 4;
    const int K = g.K; int nt = K / BK; asm volatile("" : "+s"(nt));
    unsigned voffA[2], voffB[2];
#pragma unroll
    for (int i = 0; i < 2; ++i) { int R, C; stage_rc(tid * 16 + i * 8192, R, C); const int Rb = Epi::PERM ? ((R & ~31) + perm32(R & 31)) : R;
        voffA[i] = (unsigned)(R * g.lda + C) * 2u; voffB[i] = (unsigned)(Rb * g.ldb + C) * 2u; }
    const size_t kstep = (size_t)(BK * 2);
    const size_t hstepA = (size_t)HALF * g.lda * 2, hstepB = (size_t)HALF * g.ldb * 2;
    const size_t tstepA = 2 * hstepA, tstepB = 2 * hstepB;
    const unsigned ldsw = (unsigned)wid * 1024u;
    const int aoff = lds_byte(wr * 64 + fr, fq * 8), boff = lds_byte(wc * 32 + fr, fq * 8);
#define PG8_SA(b, h) (((b) * 2 + (h)) * HTB)
#define PG8_SB(b, h) ((4 + (b) * 2 + (h)) * HTB)
#define PG8_STAGE(bufoff, gbase, voff) do { _Pragma("unroll") for (int _i = 0; _i < 2; ++_i) \
        __builtin_amdgcn_global_load_lds((const GAS unsigned*)((const GAS char*)(gbase) + (voff)[_i]), (LAS unsigned*)(lds + (bufoff) + ldsw + _i * 8192), 16, 0, 0); } while (0)
#define PG8_LDA(dst, b, h) do { _Pragma("unroll") for (int m = 0; m < 4; ++m) _Pragma("unroll") for (int k = 0; k < 2; ++k) dst[m][k] = *(const LAS bf16x8*)(lds + PG8_SA(b, h) + aoff + m * 2048 + k * 1024); } while (0)
#define PG8_LDB(dst, b, h) do { _Pragma("unroll") for (int n = 0; n < 2; ++n) _Pragma("unroll") for (int k = 0; k < 2; ++k) dst[n][k] = *(const LAS bf16x8*)(lds + PG8_SB(b, h) + boff + n * 2048 + k * 1024); } while (0)
#define PG8_MMA(ai, bj, At, Bt) do { __builtin_amdgcn_s_setprio(1); _Pragma("unroll") for (int m = 0; m < 4; ++m) _Pragma("unroll") for (int n = 0; n < 2; ++n) _Pragma("unroll") for (int k = 0; k < 2; ++k) \
        acc[ai][bj][m][n] = __builtin_amdgcn_mfma_f32_16x16x32_bf16(Bt[n][k], At[m][k], acc[ai][bj][m][n], 0, 0, 0); __builtin_amdgcn_s_setprio(0); } while (0)
#define PG8_WAIT_V(n) asm volatile("s_waitcnt vmcnt(" #n ")" ::: "memory")
#define PG8_WAIT_L(n) asm volatile("s_waitcnt lgkmcnt(" #n ")" ::: "memory")
#define PG8_BAR __builtin_amdgcn_s_barrier()
#define PG8_SCHED __builtin_amdgcn_sched_barrier(0)
    Unit cur, nxt; int ui = 0;
    if (!S.next(0, cur)) return;
    f32x4 acc[2][2][4][2];
#pragma unroll
    for (int a = 0; a < 2; ++a)
#pragma unroll
        for (int b = 0; b < 2; ++b)
#pragma unroll
            for (int m = 0; m < 4; ++m)
#pragma unroll
                for (int n = 0; n < 2; ++n) acc[a][b][m][n] = (f32x4){0.f, 0.f, 0.f, 0.f};
    bf16x8 At[4][2], B0[2][2], B1[2][2];
    const GAS char* cA = (const GAS char*)g.A + (size_t)cur.pm * tstepA; const GAS char* cB = (const GAS char*)g.Bt + (size_t)cur.pn * tstepB;
    PG8_STAGE(PG8_SB(0, 0), cB, voffB); PG8_STAGE(PG8_SB(0, 1), cB + hstepB, voffB); PG8_STAGE(PG8_SA(0, 0), cA, voffA); PG8_STAGE(PG8_SA(0, 1), cA + hstepA, voffA);
    if (wr == 1) PG8_BAR;
    PG8_WAIT_V(2); PG8_BAR;
    PG8_STAGE(PG8_SB(1, 0), cB + kstep, voffB); PG8_STAGE(PG8_SA(1, 0), cA + kstep, voffA); PG8_STAGE(PG8_SB(1, 1), cB + hstepB + kstep, voffB);
    PG8_WAIT_V(6); PG8_BAR;
    for (;;) {
        const bool has_next = S.next(ui + 1, nxt);
        const GAS char* nA = has_next ? (const GAS char*)g.A + (size_t)nxt.pm * tstepA : cA; const GAS char* nB = has_next ? (const GAS char*)g.Bt + (size_t)nxt.pn * tstepB : cB;
#pragma unroll 1
        for (int t = 0; t < nt; t += 2) {
            const bool last = (t == nt - 2);
            const GAS char* a1 = cA + (size_t)(t + 1) * kstep;
            const GAS char* a2 = last ? nA : cA + (size_t)(t + 2) * kstep; const GAS char* b2 = last ? nB : cB + (size_t)(t + 2) * kstep;
            const GAS char* a3 = a2 + kstep; const GAS char* b3 = b2 + kstep;
            PG8_LDB(B0, 0, 0); PG8_LDB(B1, 0, 1); PG8_SCHED; PG8_LDA(At, 0, 0); PG8_STAGE(PG8_SA(1, 1), a1 + hstepA, voffA);
            PG8_WAIT_V(8); PG8_WAIT_L(0); PG8_BAR; PG8_MMA(0, 0, At, B0); PG8_MMA(0, 1, At, B1); PG8_BAR; PG8_SCHED;
            PG8_LDA(At, 0, 1); PG8_STAGE(PG8_SB(0, 0), b2, voffB); PG8_STAGE(PG8_SB(0, 1), b2 + hstepB, voffB); PG8_STAGE(PG8_SA(0, 0), a2, voffA);
            PG8_WAIT_V(8); PG8_WAIT_L(0); PG8_BAR; PG8_MMA(1, 0, At, B0); PG8_MMA(1, 1, At, B1); PG8_BAR; PG8_SCHED;
            PG8_LDB(B0, 1, 0); PG8_LDB(B1, 1, 1); PG8_SCHED; PG8_LDA(At, 1, 0); PG8_STAGE(PG8_SA(0, 1), a2 + hstepA, voffA);
            PG8_WAIT_V(8); PG8_WAIT_L(0); PG8_BAR; PG8_MMA(0, 0, At, B0); PG8_MMA(0, 1, At, B1); PG8_BAR; PG8_SCHED;
            PG8_LDA(At, 1, 1); PG8_STAGE(PG8_SB(1, 0), b3, voffB); PG8_STAGE(PG8_SB(1, 1), b3 + hstepB, voffB); PG8_STAGE(PG8_SA(1, 0), a3, voffA);
            PG8_WAIT_V(8); PG8_WAIT_L(0); PG8_BAR; PG8_MMA(1, 0, At, B0); PG8_MMA(1, 1, At, B1); PG8_BAR; PG8_SCHED;
        }
        if constexpr (ALIGN_EPI) { if (wr == 0) PG8_BAR; }
        E(acc, cur, wr, wc, fr, fq);
        if (!has_next) break;
#pragma unroll
        for (int a = 0; a < 2; ++a)
#pragma unroll
            for (int b = 0; b < 2; ++b)
#pragma unroll
                for (int m = 0; m < 4; ++m)
#pragma unroll
                    for (int n = 0; n < 2; ++n) acc[a][b][m][n] = (f32x4){0.f, 0.f, 0.f, 0.f};
        cur = nxt; cA = nA; cB = nB; ++ui;
        if constexpr (ALIGN_EPI) { if (wr == 1) PG8_BAR; }
    }
    PG8_WAIT_V(0);
    if constexpr (!ALIGN_EPI) { if (wr == 0) PG8_BAR; }
    PG8_BAR;
#undef PG8_SA
#undef PG8_SB
#undef PG8_STAGE
#undef PG8_LDA
#undef PG8_LDB
#undef PG8_MMA
#undef PG8_WAIT_V
#undef PG8_WAIT_L
#undef PG8_BAR
#undef PG8_SCHED
}

struct EpiF32 {
    static constexpr bool PERM = false;
    GAS float* O; int ldc;
    __device__ __forceinline__ void operator()(const f32x4 (&acc)[2][2][4][2], const Unit& u, int wr, int wc, int fr, int fq) const {
#pragma unroll
        for (int ai = 0; ai < 2; ++ai)
#pragma unroll
            for (int m = 0; m < 4; ++m) { GAS float* rowp = O + (size_t)(u.pm * BM + ai * HALF + wr * 64 + m * 16 + fr) * ldc + u.pn * BM + wc * 32 + 4 * fq;
#pragma unroll
                for (int bj = 0; bj < 2; ++bj)
#pragma unroll
                    for (int n = 0; n < 2; ++n) *(GAS f32x4*)(rowp + bj * HALF + n * 16) = acc[ai][bj][m][n]; }
    }
};
enum { M_ID = 0, M_SCALE = 1, M_SILU = 2, M_ROPE32 = 3, M_ROPE16 = 4, M_SKIP = 5 };
template <int KIND> struct EpiStrip {
    static constexpr bool PERM = true;
    GAS bf16_t* O; int ldc; const GAS f32x4* ropeA; const GAS f32x4* ropeC; GAS float* dout; GAS bf16_t* kcs; GAS bf16_t* vcs;
    __device__ __forceinline__ void operator()(const f32x4 (&acc)[2][2][4][2], const Unit& u, int wr, int wc, int fr, int fq) const {
#pragma unroll
        for (int bj = 0; bj < 2; ++bj) {
            const int cs = u.pn * BM + bj * HALF + wc * 32;
            const int s = cs >> 5;
            int mode = M_ID; float scale = 1.f;
            if (KIND == 0) { if (s == 20) mode = M_ROPE32; else if (s == 21) mode = M_SKIP; else if ((s >= 22 && s < 38) || (s >= 86 && s < 102)) mode = M_SILU; else if (s >= 38 && s < 54) { mode = M_SCALE; scale = B_SC; } else if (s >= 102) mode = M_SKIP; }
            if (KIND == 1) { scale = A_SC; mode = (s % 3 == 2) ? M_ROPE32 : M_SCALE; }
            if (KIND == 3) { if (s < 32) { scale = C_SC; mode = (s & 1) ? M_SCALE : M_ROPE16; } else if (s < 36) { mode = (s & 1) ? M_ID : M_ROPE16; } else if (s < 40) mode = M_ID; else mode = M_SILU; }
            if (mode == M_SKIP) continue;
            const int c0 = cs + 8 * fq;
#pragma unroll
            for (int ai = 0; ai < 2; ++ai)
#pragma unroll
                for (int m = 0; m < 4; ++m) {
                    const int row = u.pm * BM + ai * HALF + wr * 64 + m * 16 + fr;
                    f32x4 v0 = acc[ai][bj][m][0], v1 = acc[ai][bj][m][1];
                    if (mode == M_SILU) {
#pragma unroll
                        for (int i = 0; i < 4; ++i) { v0[i] = silu_f(v0[i]); v1[i] = silu_f(v1[i]); }
                    } else if (mode == M_ROPE32) {
                        const int pos = row_pos(row);
                        const GAS f32x4* tp = ropeA + (size_t)pos * 8 + (fq & 1) * 4;
                        const f32x4 t0 = tp[0], t1 = tp[1], t2 = tp[2], t3 = tp[3];
                        const float sg = (fq < 2) ? -1.f : 1.f;
                        f32x4 p0, p1;
#pragma unroll
                        for (int i = 0; i < 4; ++i) { p0[i] = __shfl_xor(v0[i], 32); p1[i] = __shfl_xor(v1[i], 32); }
                        v0[0] = v0[0] * t0[0] + sg * p0[0] * t0[1]; v0[1] = v0[1] * t0[2] + sg * p0[1] * t0[3];
                        v0[2] = v0[2] * t1[0] + sg * p0[2] * t1[1]; v0[3] = v0[3] * t1[2] + sg * p0[3] * t1[3];
                        v1[0] = v1[0] * t2[0] + sg * p1[0] * t2[1]; v1[1] = v1[1] * t2[2] + sg * p1[1] * t2[3];
                        v1[2] = v1[2] * t3[0] + sg * p1[2] * t3[1]; v1[3] = v1[3] * t3[2] + sg * p1[3] * t3[3];
                    } else if (mode == M_ROPE16) {
                        const int pos = row_pos(row);
                        const GAS f32x4* tp = ropeC + (size_t)pos * 4;
                        const f32x4 t0 = tp[0], t1 = tp[1], t2 = tp[2], t3 = tp[3];
                        const float sg = (fq == 0) ? -1.f : 1.f;
                        f32x4 p0, p1;
#pragma unroll
                        for (int i = 0; i < 4; ++i) { p0[i] = __shfl_xor(v0[i], 16); p1[i] = __shfl_xor(v1[i], 16); }
                        if (fq < 2) {
                            v0[0] = v0[0] * t0[0] + sg * p0[0] * t0[1]; v0[1] = v0[1] * t0[2] + sg * p0[1] * t0[3];
                            v0[2] = v0[2] * t1[0] + sg * p0[2] * t1[1]; v0[3] = v0[3] * t1[2] + sg * p0[3] * t1[3];
                            v1[0] = v1[0] * t2[0] + sg * p1[0] * t2[1]; v1[1] = v1[1] * t2[2] + sg * p1[1] * t2[3];
                            v1[2] = v1[2] * t3[0] + sg * p1[2] * t3[1]; v1[3] = v1[3] * t3[2] + sg * p1[3] * t3[3];
                        }
                    }
                    if (KIND == 3 && s >= 32 && s < 40) {
                        const int ck = c0 - Z1_K;
                        const bool isv = ck >= 128; const int cc = isv ? ck - 128 : ck;
                        if (row >= MP) {
                            const int bs = (row - MP) >> 6, t = (row - MP) & 63;
                            GAS float* dp = dout + (isv ? O_CV_S : O_CK_S) + ((size_t)bs * 128 + 64 + t) * 128 + cc;
                            *(GAS f32x4*)dp = v0; *(GAS f32x4*)(dp + 4) = v1;
                            GAS bf16_t* bp = (isv ? vcs : kcs) + ((size_t)bs * 192 + 128 + t) * 128 + cc;
                            u32x4 w; w.x = pk2(v0[0], v0[1]); w.y = pk2(v0[2], v0[3]); w.z = pk2(v1[0], v1[1]); w.w = pk2(v1[2], v1[3]);
                            *(GAS u32x4*)bp = w;
                        } else if ((row & 8191) >= 8064) {
                            const int b = row >> 13, p = (row & 8191) - 8064;
                            GAS float* dp = dout + (isv ? O_CV_P : O_CK_P) + ((size_t)b * 128 + p) * 128 + cc;
                            *(GAS f32x4*)dp = v0; *(GAS f32x4*)(dp + 4) = v1;
                        }
                    }
                    if (mode == M_SCALE || ((mode == M_ROPE32 || mode == M_ROPE16) && scale != 1.f)) { v0 = v0 * scale; v1 = v1 * scale; }
                    u32x4 w; w.x = pk2(v0[0], v0[1]); w.y = pk2(v0[2], v0[3]); w.z = pk2(v1[0], v1[1]); w.w = pk2(v1[2], v1[3]);
                    *(GAS u32x4*)(O + (size_t)row * ldc + c0) = w;
                    asm volatile("" ::: "memory");
                }
        }
    }
};
}

namespace att {
constexpr int LDS_K0 = 0  , LDS_V0 = 49152  , LDS_BIAS = 81920, LDS_SCHED = 83968, LDS_OST = 86016  , OSTP = 144;
struct AUnit {
    int t_lo, t_hi, t_split;
    const GAS bf16_t *k1, *k2, *kr1, *kr2, *v1, *v2;
    int kpitch, krpitch1, krpitch2;
    bool wactive; int wt_lo, wt_hi;
    const GAS bf16_t* q; int qpitch;
    GAS bf16_t* o; const GAS bf16_t* g; int opitch;
    int qpos0, wchunk;
    float sink;
    int nostore;
};
__device__ __forceinline__ s16x4 vtr(const LAS char* p) { typedef short v4i16_t __attribute__((ext_vector_type(4))); return __builtin_bit_cast(s16x4, __builtin_amdgcn_ds_read_tr16_b64_v4i16((LAS v4i16_t*)p)); }
__device__ __forceinline__ float xhalf_max(float m) { auto rr = __builtin_amdgcn_permlane32_swap(__float_as_uint(m), __float_as_uint(m), false, false); return fmaxf(__uint_as_float(rr[0]), __uint_as_float(rr[1])); }
__device__ __forceinline__ float xhalf_sum(float m) { auto rr = __builtin_amdgcn_permlane32_swap(__float_as_uint(m), __float_as_uint(m), false, false); return __uint_as_float(rr[0]) + __uint_as_float(rr[1]); }

__device__ __forceinline__ void glds16(const GAS void* gsrc, unsigned lds_dst) { unsigned keep;
    asm volatile("s_mov_b32 %0, m0\n\ts_mov_b32 m0, %2\n\ts_nop 0\n\tglobal_load_lds_dwordx4 %1, off\n\ts_mov_b32 m0, %0" : "=&s"(keep) : "v"(gsrc), "s"(lds_dst) : "memory"); }
__device__ __forceinline__ void glds16_nt(const GAS void* gsrc, unsigned lds_dst) { unsigned keep;
    asm volatile("s_mov_b32 %0, m0\n\ts_mov_b32 m0, %2\n\ts_nop 0\n\tglobal_load_lds_dwordx4 %1, off nt\n\ts_mov_b32 m0, %0" : "=&s"(keep) : "v"(gsrc), "s"(lds_dst) : "memory"); }
constexpr float ATT_THR = 8.f;
#define ATT_WAITV(n) asm volatile("s_waitcnt vmcnt(" #n ") lgkmcnt(0)" ::: "memory")
template <int MODE>
__device__ __forceinline__ void attn_unit(LAS unsigned char* lds, const AUnit& U) {
    constexpr int DQK = (MODE == 0) ? 96 : 64, ND = DQK / 16, KSLOT = (DQK / 8) * 1024, VSLOT = 8192, NPW = (MODE == 0) ? 3 : 2;
    int tid = threadIdx.x; asm volatile("" : "+v"(tid));
    const int lane = tid & 63, w = __builtin_amdgcn_readfirstlane(tid >> 6), r32 = lane & 31, hh = lane >> 5;
    bf16x8 qf[ND];
    float m_ref = (MODE == 2) ? U.sink : 0.f, l = (MODE == 2 && hh == 0) ? 1.f : 0.f;
    bool first = (MODE != 2);
    f32x16 o0, o1, p0, p1, negm;
#pragma unroll
    for (int r = 0; r < 16; ++r) { o0[r] = 0.f; o1[r] = 0.f; p0[r] = 0.f; p1[r] = 0.f; negm[r] = -m_ref; }
    const int krow_ = 8 * w + (lane >> 3);
    const size_t koff = (size_t)krow_ * U.kpitch + (((lane & 7) ^ ((krow_ >> 1) & 7)) * 8);
    const size_t voff = (size_t)(16 * (w & 3) + (lane >> 2)) * U.kpitch + 32 * (w >> 2) + 8 * (lane & 3);
    const size_t roff1 = (size_t)lane * U.krpitch1 + (w & 3) * 8, roff2 = (size_t)lane * U.krpitch2 + (w & 3) * 8;
    const unsigned lds0 = (unsigned)(uintptr_t)lds;
#define ATT_DMA(t, slot) do { const bool s2_ = (t) >= U.t_split; const size_t kk_ = (size_t)(s2_ ? (t) - U.t_split : (t)) * 64; \
        glds16((s2_ ? U.k2 : U.k1) + kk_ * U.kpitch + koff, (unsigned)__builtin_amdgcn_readfirstlane(lds0 + LDS_K0 + (slot) * KSLOT + w * 1024)); \
        if (MODE == 0) glds16(s2_ ? U.kr2 + kk_ * U.krpitch2 + roff2 : U.kr1 + kk_ * U.krpitch1 + roff1, (unsigned)__builtin_amdgcn_readfirstlane(lds0 + LDS_K0 + (slot) * KSLOT + (8 + (w & 3)) * 1024)); \
        glds16((s2_ ? U.v2 : U.v1) + kk_ * U.kpitch + voff, (unsigned)__builtin_amdgcn_readfirstlane(lds0 + LDS_V0 + (slot) * VSLOT + w * 1024)); } while (0)
#define ACTIVE(j) (U.wactive && (j) >= U.wt_lo && (j) <= U.wt_hi)
#define ATT_WAIT_BAR(ahead) do { if ((ahead) >= 2) { if (NPW == 3) ATT_WAITV(6); else ATT_WAITV(4); } else if ((ahead) == 1) { if (NPW == 3) ATT_WAITV(3); else ATT_WAITV(2); } else ATT_WAITV(0); \
        __builtin_amdgcn_s_barrier(); asm volatile("" ::: "memory"); } while (0)
#define ATT_QKMAX(j, slot) do { \
        const LAS unsigned char* kq = lds + LDS_K0 + (slot) * KSLOT + r32 * 128; \
        _Pragma("unroll") for (int d0 = 0; d0 < ND; ++d0) { const int sw_ = (((2 * d0 + hh) ^ ((r32 >> 1) & 7)) & 7) * 16 + (d0 >= 4 ? 8192 : 0); \
            const bf16x8 ka = *(const LAS bf16x8*)(kq + sw_), kb2 = *(const LAS bf16x8*)(kq + 4096 + sw_); \
            p0 = __builtin_amdgcn_mfma_f32_32x32x16_bf16(ka, qf[d0], d0 == 0 ? negm : p0, 0, 0, 0); \
            p1 = __builtin_amdgcn_mfma_f32_32x32x16_bf16(kb2, qf[d0], d0 == 0 ? negm : p1, 0, 0, 0); } \
        if (MODE == 1) { const LAS float* bl = (const LAS float*)(lds + LDS_BIAS); \
            if (U.wchunk - (j) >= 3) { const float bc = bl[256]; _Pragma("unroll") for (int r = 0; r < 16; ++r) { p0[r] += bc; p1[r] += bc; } } \
            else { const int rel0 = U.qpos0 + r32 - 64 * (j) - 4 * hh; \
                _Pragma("unroll") for (int r = 0; r < 16; ++r) { const int rel = rel0 - ((r & 3) + 8 * (r >> 2)); \
                    p0[r] += bl[min(max(rel, -128), 128) + 128]; p1[r] += bl[min(max(rel - 32, -128), 128) + 128]; } } } \
        float rm = fmaxf(p0[0], p1[0]); \
        _Pragma("unroll") for (int r = 1; r < 16; ++r) rm = fmaxf(rm, fmaxf(p0[r], p1[r])); \
        rm = xhalf_max(rm); \
        if (first || __builtin_amdgcn_ballot_w64(rm > ATT_THR) != 0ull) { \
            const float dl = first ? rm : fmaxf(rm, 0.f); \
            m_ref += dl; \
            _Pragma("unroll") for (int r = 0; r < 16; ++r) { p0[r] -= dl; p1[r] -= dl; } \
            if (!first) { const float f = __builtin_amdgcn_exp2f(-dl); l *= f; \
                _Pragma("unroll") for (int r = 0; r < 16; ++r) { o0[r] *= f; o1[r] *= f; } } \
            _Pragma("unroll") for (int r = 0; r < 16; ++r) negm[r] = -m_ref; \
            first = false; } } while (0)
#define ATT_EXPPV(slot) do { \
        float ps = 0.f; \
        _Pragma("unroll") for (int r = 0; r < 16; ++r) { p0[r] = __builtin_amdgcn_exp2f(p0[r]); p1[r] = __builtin_amdgcn_exp2f(p1[r]); ps += p0[r] + p1[r]; } \
        l += ps; \
        u32x4 pw[4]; \
        pw[0] = (u32x4){pk2(p0[0], p0[1]), pk2(p0[2], p0[3]), pk2(p0[4], p0[5]), pk2(p0[6], p0[7])}; \
        pw[1] = (u32x4){pk2(p0[8], p0[9]), pk2(p0[10], p0[11]), pk2(p0[12], p0[13]), pk2(p0[14], p0[15])}; \
        pw[2] = (u32x4){pk2(p1[0], p1[1]), pk2(p1[2], p1[3]), pk2(p1[4], p1[5]), pk2(p1[6], p1[7])}; \
        pw[3] = (u32x4){pk2(p1[8], p1[9]), pk2(p1[10], p1[11]), pk2(p1[12], p1[13]), pk2(p1[14], p1[15])}; \
        const LAS char* vq = (const LAS char*)lds + LDS_V0 + (slot) * VSLOT + ((lane >> 4) & 1) * 32 + (lane & 3) * 8 + (4 * hh + ((lane & 15) >> 2)) * 64; \
        _Pragma("unroll") for (int kg = 0; kg < 4; ++kg) { \
            const bf16x8 pb = __builtin_bit_cast(bf16x8, pw[kg]); \
            const s16x4 a0 = vtr(vq + kg * 1024), a1 = vtr(vq + kg * 1024 + 512), b0 = vtr(vq + 4096 + kg * 1024), b1 = vtr(vq + 4096 + kg * 1024 + 512); \
            const bf16x8 vf0 = (bf16x8){a0[0], a0[1], a0[2], a0[3], a1[0], a1[1], a1[2], a1[3]}; \
            const bf16x8 vf1 = (bf16x8){b0[0], b0[1], b0[2], b0[3], b1[0], b1[1], b1[2], b1[3]}; \
            o0 = __builtin_amdgcn_mfma_f32_32x32x16_bf16(vf0, pb, o0, 0, 0, 0); \
            o1 = __builtin_amdgcn_mfma_f32_32x32x16_bf16(vf1, pb, o1, 0, 0, 0); } } while (0)
    const int t_lo = U.t_lo, t_hi = U.t_hi;
    ATT_DMA(t_lo, 0);
    if (t_lo + 1 <= t_hi) ATT_DMA(t_lo + 1, 1);
    if (t_lo + 2 <= t_hi) ATT_DMA(t_lo + 2, 2);
    if (MODE != 0 && U.wactive) {
        LAS unsigned char* qs = lds + LDS_OST + w * (32 * OSTP);
        u32x4 qv[4];
#pragma unroll
        for (int i = 0; i < 4; ++i) qv[i] = *(const GAS u32x4*)(U.q + (size_t)(i * 8 + (lane >> 3)) * U.qpitch + (lane & 7) * 8);
#pragma unroll
        for (int i = 0; i < 4; ++i) *(LAS u32x4*)(qs + (i * 8 + (lane >> 3)) * OSTP + (lane & 7) * 16) = qv[i];
        asm volatile("s_waitcnt lgkmcnt(0)" ::: "memory");
#pragma unroll
        for (int d0 = 0; d0 < ND; ++d0) { qf[d0] = *(const LAS bf16x8*)(qs + r32 * OSTP + (2 * d0 + hh) * 16); asm volatile("" : "+v"(qf[d0])); }
    } else {
#pragma unroll
    for (int d0 = 0; d0 < ND; ++d0) { qf[d0] = U.wactive ? *(const GAS bf16x8*)(U.q + (size_t)r32 * U.qpitch + d0 * 16 + hh * 8) : (bf16x8){0, 0, 0, 0, 0, 0, 0, 0};
        asm volatile("" : "+v"(qf[d0])); }
    }
    ATT_WAIT_BAR(min(t_lo + 2, t_hi) - t_lo);
    int slot = 0;
#pragma unroll 1
    for (int i = t_lo; i <= t_hi; ++i) {
        if (i + 3 <= t_hi) ATT_DMA(i + 3, (slot + 3) & 3);
        if (ACTIVE(i)) { ATT_QKMAX(i, slot); ATT_EXPPV(slot); }
        ATT_WAIT_BAR(min(i + 3, t_hi) - (i + 1));
        slot = (slot + 1) & 3;
    }
#undef ATT_DMA
#undef ACTIVE
#undef ATT_WAIT_BAR
#undef ATT_QKMAX
#undef ATT_EXPPV
    if (U.wactive && !U.nostore) {
        l = xhalf_sum(l);
        const float inv = 1.0f / l;
        LAS unsigned char* stg = lds + LDS_OST + w * (32 * OSTP);
#pragma unroll
        for (int rg = 0; rg < 4; ++rg) {
            *(LAS u32x2*)(stg + r32 * OSTP + (8 * rg + 4 * hh) * 2) = (u32x2){pk2(o0[4 * rg] * inv, o0[4 * rg + 1] * inv), pk2(o0[4 * rg + 2] * inv, o0[4 * rg + 3] * inv)};
            *(LAS u32x2*)(stg + r32 * OSTP + (32 + 8 * rg + 4 * hh) * 2) = (u32x2){pk2(o1[4 * rg] * inv, o1[4 * rg + 1] * inv), pk2(o1[4 * rg + 2] * inv, o1[4 * rg + 3] * inv)};
        }
        asm volatile("s_waitcnt lgkmcnt(0)" ::: "memory");
#pragma unroll
        for (int i = 0; i < 4; ++i) {
            const int row = i * 8 + (lane >> 3), ch = lane & 7;
            const u32x4 ov = *(const LAS u32x4*)(stg + row * OSTP + ch * 16);
            const u32x4 gv = *(const GAS u32x4*)(U.g + (size_t)row * U.opitch + ch * 8);
            u32x4 r;
            r.x = pk2(bflo(ov.x) * bflo(gv.x), bfhi(ov.x) * bfhi(gv.x)); r.y = pk2(bflo(ov.y) * bflo(gv.y), bfhi(ov.y) * bfhi(gv.y));
            r.z = pk2(bflo(ov.z) * bflo(gv.z), bfhi(ov.z) * bfhi(gv.z)); r.w = pk2(bflo(ov.w) * bflo(gv.w), bfhi(ov.w) * bfhi(gv.w));
            *(GAS u32x4*)(U.o + (size_t)row * U.opitch + ch * 8) = r;
        }
    }
}
__device__ __forceinline__ void attn_unit_mla(LAS unsigned char* lds, const AUnit& U) {
    constexpr int ND = 6, KSLOT = 12288, VSLOT = 8192;
    int tid = threadIdx.x; asm volatile("" : "+v"(tid));
    const int lane = tid & 63, w = __builtin_amdgcn_readfirstlane(tid >> 6), r32 = lane & 31, hh = lane >> 5;
    const int rg = w & 3, kh = w >> 2;
    bf16x8 qf[2][ND];
    float m_ref[2] = {0.f, 0.f}, l[2] = {0.f, 0.f};
    bool first = true;
    f32x16 o[2][2];
#pragma unroll
    for (int r = 0; r < 16; ++r) { o[0][0][r] = 0.f; o[0][1][r] = 0.f; o[1][0][r] = 0.f; o[1][1][r] = 0.f; }
    const int krow_ = 8 * w + (lane >> 3), rrow_ = 16 * (w & 3) + (lane >> 2);
    const size_t koff = (size_t)krow_ * U.kpitch + (((lane & 7) ^ ((krow_ >> 1) & 7)) * 8);
    const size_t voff = (size_t)(16 * (w & 3) + (lane >> 2)) * U.kpitch + 32 * (w >> 2) + 8 * (lane & 3);
    const int rsw_ = ((lane & 3) ^ ((rrow_ >> 2) & 3)) * 8;
    const size_t roff1 = (size_t)rrow_ * U.krpitch1 + rsw_, roff2 = (size_t)rrow_ * U.krpitch2 + rsw_;
    const unsigned lds0 = (unsigned)(uintptr_t)lds;
    const bool once = U.t_split < (1 << 29);
#define MLA_DMA(t, slot) do { const bool s2_ = (t) >= U.t_split; const size_t kk_ = (size_t)(s2_ ? (t) - U.t_split : (t)) * 64; \
        if (once && !s2_) {     \
        glds16_nt(U.k1 + kk_ * U.kpitch + koff, (unsigned)__builtin_amdgcn_readfirstlane(lds0 + LDS_K0 + (slot) * KSLOT + w * 1024)); \
        glds16_nt(U.kr1 + kk_ * U.krpitch1 + roff1, (unsigned)__builtin_amdgcn_readfirstlane(lds0 + LDS_K0 + (slot) * KSLOT + (8 + (w & 3)) * 1024)); \
        glds16_nt(U.v1 + kk_ * U.kpitch + voff, (unsigned)__builtin_amdgcn_readfirstlane(lds0 + LDS_V0 + (slot) * VSLOT + w * 1024)); } else { \
        glds16((s2_ ? U.k2 : U.k1) + kk_ * U.kpitch + koff, (unsigned)__builtin_amdgcn_readfirstlane(lds0 + LDS_K0 + (slot) * KSLOT + w * 1024)); \
        glds16(s2_ ? U.kr2 + kk_ * U.krpitch2 + roff2 : U.kr1 + kk_ * U.krpitch1 + roff1, (unsigned)__builtin_amdgcn_readfirstlane(lds0 + LDS_K0 + (slot) * KSLOT + (8 + (w & 3)) * 1024)); \
        glds16((s2_ ? U.v2 : U.v1) + kk_ * U.kpitch + voff, (unsigned)__builtin_amdgcn_readfirstlane(lds0 + LDS_V0 + (slot) * VSLOT + w * 1024)); } } while (0)
#define MLA_WAIT_BAR(ahead) do { if ((ahead) >= 2) ATT_WAITV(6); else if ((ahead) == 1) ATT_WAITV(3); else ATT_WAITV(0); __builtin_amdgcn_s_barrier(); asm volatile("" ::: "memory"); } while (0)
    const int t_lo = U.t_lo, t_hi = U.t_hi;
    MLA_DMA(t_lo, 0);
    if (t_lo + 1 <= t_hi) MLA_DMA(t_lo + 1, 1);
    if (t_lo + 2 <= t_hi) MLA_DMA(t_lo + 2, 2);
    if (U.wactive) {
        LAS unsigned char* qs = lds + LDS_OST + w * 6144;
#pragma unroll
        for (int rb = 0; rb < 2; ++rb) {
            u32x4 qv[6];
#pragma unroll
            for (int i = 0; i < 6; ++i) { const int e = i * 64 + lane, row = e / 12, ch = e % 12; qv[i] = *(const GAS u32x4*)(U.q + (size_t)(32 * rb + row) * U.qpitch + ch * 8); }
#pragma unroll
            for (int i = 0; i < 6; ++i) { const int e = i * 64 + lane; *(LAS u32x4*)(qs + e * 16) = qv[i]; }
            asm volatile("s_waitcnt lgkmcnt(0)" ::: "memory");
#pragma unroll
            for (int d0 = 0; d0 < ND; ++d0) { qf[rb][d0] = *(const LAS bf16x8*)(qs + r32 * 192 + (2 * d0 + hh) * 16); asm volatile("" : "+v"(qf[rb][d0])); }
            asm volatile("s_waitcnt lgkmcnt(0)" ::: "memory");
        }
    } else {
#pragma unroll
        for (int rb = 0; rb < 2; ++rb)
#pragma unroll
            for (int d0 = 0; d0 < ND; ++d0) qf[rb][d0] = (bf16x8){0, 0, 0, 0, 0, 0, 0, 0};
    }
    MLA_WAIT_BAR(min(t_lo + 2, t_hi) - t_lo);
    int slot = 0;
#pragma unroll 1
    for (int i = t_lo; i <= t_hi; ++i) {
        if (i + 3 <= t_hi) MLA_DMA(i + 3, (slot + 3) & 3);
        if (U.wactive && i >= U.wt_lo && i <= U.wt_hi) {
            f32x16 p[2];
            const LAS unsigned char* kq = lds + LDS_K0 + slot * KSLOT;
            const int krd_ = r32 + 32 * kh;
#pragma unroll
            for (int d0 = 0; d0 < ND; ++d0) {
                const int ko_ = d0 < 4 ? krd_ * 128 + ((((2 * d0 + hh) ^ ((r32 >> 1) & 7)) & 7) * 16) : 8192 + krd_ * 64 + ((((2 * (d0 - 4) + hh) ^ ((r32 >> 2) & 3)) & 3) * 16);
                const bf16x8 kf = *(const LAS bf16x8*)(kq + ko_);
                if (d0 == 0) { f32x16 z;
#pragma unroll
                    for (int r = 0; r < 16; ++r) z[r] = 0.f;
                    p[0] = __builtin_amdgcn_mfma_f32_32x32x16_bf16(kf, qf[0][0], z, 0, 0, 0); p[1] = __builtin_amdgcn_mfma_f32_32x32x16_bf16(kf, qf[1][0], z, 0, 0, 0);
                } else { p[0] = __builtin_amdgcn_mfma_f32_32x32x16_bf16(kf, qf[0][d0], p[0], 0, 0, 0); p[1] = __builtin_amdgcn_mfma_f32_32x32x16_bf16(kf, qf[1][d0], p[1], 0, 0, 0); }
            }
            float rm[2];
#pragma unroll
            for (int rb = 0; rb < 2; ++rb) { float x = p[rb][0];
#pragma unroll
                for (int r = 1; r < 16; ++r) x = fmaxf(x, p[rb][r]);
                rm[rb] = xhalf_max(x); }
            if (first || __builtin_amdgcn_ballot_w64(rm[0] - m_ref[0] > ATT_THR || rm[1] - m_ref[1] > ATT_THR) != 0ull) {
#pragma unroll
                for (int rb = 0; rb < 2; ++rb) { const float mn = first ? rm[rb] : fmaxf(m_ref[rb], rm[rb]);
                    if (!first) { const float f = __builtin_amdgcn_exp2f(m_ref[rb] - mn); l[rb] *= f;
#pragma unroll
                        for (int r = 0; r < 16; ++r) { o[rb][0][r] *= f; o[rb][1][r] *= f; } }
                    m_ref[rb] = mn; }
                first = false;
            }
            u32x4 pw[2][2];
#pragma unroll
            for (int rb = 0; rb < 2; ++rb) { float ps = 0.f;
#pragma unroll
                for (int r = 0; r < 16; ++r) { p[rb][r] = __builtin_amdgcn_exp2f(p[rb][r] - m_ref[rb]); ps += p[rb][r]; }
                l[rb] += ps;
                pw[rb][0] = (u32x4){pk2(p[rb][0], p[rb][1]), pk2(p[rb][2], p[rb][3]), pk2(p[rb][4], p[rb][5]), pk2(p[rb][6], p[rb][7])};
                pw[rb][1] = (u32x4){pk2(p[rb][8], p[rb][9]), pk2(p[rb][10], p[rb][11]), pk2(p[rb][12], p[rb][13]), pk2(p[rb][14], p[rb][15])}; }
            const LAS char* vq = (const LAS char*)lds + LDS_V0 + slot * VSLOT + ((lane >> 4) & 1) * 32 + (lane & 3) * 8 + (4 * hh + ((lane & 15) >> 2)) * 64 + kh * 2048;
#pragma unroll
            for (int ks = 0; ks < 2; ++ks) {
                const s16x4 a0 = vtr(vq + ks * 1024), a1 = vtr(vq + ks * 1024 + 512), b0 = vtr(vq + 4096 + ks * 1024), b1 = vtr(vq + 4096 + ks * 1024 + 512);
                const bf16x8 vf0 = (bf16x8){a0[0], a0[1], a0[2], a0[3], a1[0], a1[1], a1[2], a1[3]};
                const bf16x8 vf1 = (bf16x8){b0[0], b0[1], b0[2], b0[3], b1[0], b1[1], b1[2], b1[3]};
#pragma unroll
                for (int rb = 0; rb < 2; ++rb) { const bf16x8 pb = __builtin_bit_cast(bf16x8, pw[rb][ks]);
                    o[rb][0] = __builtin_amdgcn_mfma_f32_32x32x16_bf16(vf0, pb, o[rb][0], 0, 0, 0);
                    o[rb][1] = __builtin_amdgcn_mfma_f32_32x32x16_bf16(vf1, pb, o[rb][1], 0, 0, 0); }
            }
        }
        MLA_WAIT_BAR(min(i + 3, t_hi) - (i + 1));
        slot = (slot + 1) & 3;
    }
#undef MLA_DMA
#undef MLA_WAIT_BAR
    LAS float* X = (LAS float*)(lds + rg * 17408) + lane;
    if (U.wactive && kh == 1) {
#pragma unroll
        for (int rb = 0; rb < 2; ++rb) { X[(0 + rb) * 64] = first ? -1e30f : m_ref[rb]; X[(2 + rb) * 64] = xhalf_sum(l[rb]);
#pragma unroll
            for (int dh = 0; dh < 2; ++dh)
#pragma unroll
                for (int r = 0; r < 16; ++r) X[(4 + rb * 32 + dh * 16 + r) * 64] = o[rb][dh][r]; }
    }
    asm volatile("s_waitcnt lgkmcnt(0)" ::: "memory"); __builtin_amdgcn_s_barrier(); asm volatile("" ::: "memory");
    if (U.wactive && kh == 0) {
        LAS unsigned char* stg = lds + LDS_OST + rg * (64 * OSTP);
#pragma unroll
        for (int rb = 0; rb < 2; ++rb) {
            const float m0 = first ? -1e30f : m_ref[rb], m1 = X[(0 + rb) * 64], l0 = xhalf_sum(l[rb]), l1 = X[(2 + rb) * 64];
            const float mm = fmaxf(m0, m1), f0 = __builtin_amdgcn_exp2f(m0 - mm), f1 = __builtin_amdgcn_exp2f(m1 - mm);
            const float inv = 1.0f / (l0 * f0 + l1 * f1), c0 = f0 * inv, c1 = f1 * inv;
#pragma unroll
            for (int dh = 0; dh < 2; ++dh)
#pragma unroll
                for (int rq = 0; rq < 4; ++rq) {
                    float v[4];
#pragma unroll
                    for (int e = 0; e < 4; ++e) v[e] = o[rb][dh][4 * rq + e] * c0 + X[(4 + rb * 32 + dh * 16 + 4 * rq + e) * 64] * c1;
                    *(LAS u32x2*)(stg + (32 * rb + r32) * OSTP + (32 * dh + 8 * rq + 4 * hh) * 2) = (u32x2){pk2(v[0], v[1]), pk2(v[2], v[3])};
                }
        }
        asm volatile("s_waitcnt lgkmcnt(0)" ::: "memory");
#pragma unroll
        for (int i = 0; i < 8; ++i) {
            const int row = i * 8 + (lane >> 3), ch = lane & 7;
            const u32x4 ov = *(const LAS u32x4*)(stg + row * OSTP + ch * 16);
            const u32x4 gv = *(const GAS u32x4*)(U.g + (size_t)row * U.opitch + ch * 8);
            u32x4 r;
            r.x = pk2(bflo(ov.x) * bflo(gv.x), bfhi(ov.x) * bfhi(gv.x)); r.y = pk2(bflo(ov.y) * bflo(gv.y), bfhi(ov.y) * bfhi(gv.y));
            r.z = pk2(bflo(ov.z) * bflo(gv.z), bfhi(ov.z) * bfhi(gv.z)); r.w = pk2(bflo(ov.w) * bflo(gv.w), bfhi(ov.w) * bfhi(gv.w));
            *(GAS u32x4*)(U.o + (size_t)row * U.opitch + ch * 8) = r;
        }
    }
    asm volatile("s_waitcnt lgkmcnt(0)" ::: "memory"); __builtin_amdgcn_s_barrier(); asm volatile("" ::: "memory");
}
__device__ __forceinline__ unsigned unit_ask(GAS unsigned* ctr) { return threadIdx.x == 0 ? __hip_atomic_fetch_add(ctr, 1u, __ATOMIC_RELAXED, __HIP_MEMORY_SCOPE_AGENT) : 0u; }
__device__ __forceinline__ int unit_take(LAS unsigned char* lds, unsigned asked) {
    volatile LAS int* sw = (volatile LAS int*)(lds + LDS_SCHED);
    __syncthreads();
    if (threadIdx.x == 0) *sw = (int)asked;
    __syncthreads();
    return __builtin_amdgcn_readfirstlane(*sw);
}
}


#define XB_TMO      128
#define XB_XCNT(j)  (256  + 64 * (j))
#define XB_XSUB(j)  (1280 + 64 * (j))
#define XB_XGEN(j)  (2304 + 64 * (j))
#define XB_TOP      3328
#define XB_TOPGEN   3392
#define XCD_BAR_WORDS 3456
#define XB_SPIN_CAP (1u << 22)
__device__ __forceinline__ unsigned xb_ld(unsigned* p)              { return __hip_atomic_load(p, __ATOMIC_RELAXED, __HIP_MEMORY_SCOPE_AGENT); }
__device__ __forceinline__ unsigned xb_add(unsigned* p, unsigned v) { return __hip_atomic_fetch_add(p, v, __ATOMIC_RELAXED, __HIP_MEMORY_SCOPE_AGENT); }
__device__ __forceinline__ unsigned xb_xcc_id() { return (unsigned)__builtin_amdgcn_s_getreg((3 << 11) | 20) & 0xFu; }
#define XB_SPIN(cond, bar) do { unsigned _sp = 0; while (cond) { __builtin_amdgcn_s_sleep(1); \
    if ((++_sp & 255u) == 0u) { if (xb_ld(&(bar)[XB_TMO])) break; if (_sp > XB_SPIN_CAP) { atomicAdd(&(bar)[XB_TMO], 1u); break; } } } } while (0)
struct XcdBarrier { unsigned* bar; unsigned x; volatile LAS unsigned* st; };
__device__ __forceinline__ XcdBarrier xcd_barrier_post(unsigned* bar, volatile LAS unsigned* st) {
    XcdBarrier b; b.bar = bar; b.x = xb_xcc_id(); b.st = st;
    if (threadIdx.x == 0) (void)xb_add(&bar[XB_XCNT(b.x)], 1u);
    return b;
}
__device__ __forceinline__ void xcd_barrier_complete(unsigned* bar, unsigned x, unsigned& nloc, unsigned& nx) {
    const unsigned G = gridDim.x * gridDim.y * gridDim.z;
    unsigned sum, cnt, mine, sp = 0u;
    for (;;) {
        sum = 0u; cnt = 0u; mine = 0u;
#pragma unroll
        for (unsigned j = 0; j < 16; ++j) { const unsigned c = xb_ld(&bar[XB_XCNT(j)]); sum += c; cnt += (c > 0u) ? 1u : 0u; mine = (j == x) ? c : mine; }
        if (sum == G) break;
        __builtin_amdgcn_s_sleep(1);
        if ((++sp & 255u) == 0u) { if (xb_ld(&bar[XB_TMO])) break; if (sp > XB_SPIN_CAP) { atomicAdd(&bar[XB_TMO], 1u); break; } }
    }
    nloc = mine > 0u ? mine : 1u; nx = cnt > 0u ? cnt : 1u;
}
__device__ __forceinline__ void xcd_barrier(const XcdBarrier& b) {
    asm volatile("s_waitcnt vmcnt(0)" ::: "memory");
    __syncthreads();
    if (threadIdx.x == 0) {
        unsigned* bar = b.bar;
        __builtin_amdgcn_s_waitcnt(0);
        unsigned nloc = b.st[0], nx = b.st[1];
        if (nloc == 0u) { xcd_barrier_complete(bar, b.x, nloc, nx); b.st[0] = nloc; b.st[1] = nx; }
        const unsigned old = xb_add(&bar[XB_XSUB(b.x)], 1u);
        const unsigned gen = old / nloc;
        if (old + 1u == (gen + 1u) * nloc) {
            __builtin_amdgcn_fence(__ATOMIC_RELEASE, "agent");
            asm volatile("s_waitcnt vmcnt(0)" ::: "memory");
            const unsigned og = xb_add(&bar[XB_TOP], 1u);
            const unsigned tg = og / nx;
            if (og + 1u == (tg + 1u) * nx) xb_add(&bar[XB_TOPGEN], 1u);
            else XB_SPIN(xb_ld(&bar[XB_TOPGEN]) == tg, bar);
            __builtin_amdgcn_fence(__ATOMIC_ACQUIRE, "agent");
            xb_add(&bar[XB_XGEN(b.x)], 1u);
            asm volatile("s_waitcnt vmcnt(0)" ::: "memory");
        } else {
            XB_SPIN(xb_ld(&bar[XB_XGEN(b.x)]) == gen, bar);
            __builtin_amdgcn_fence(__ATOMIC_ACQUIRE, "agent");
            asm volatile("s_waitcnt vmcnt(0)" ::: "memory");
        }
    }
    __syncthreads();
}

struct Args { const float* in[22]; float* out; unsigned char* ws; int ph_lo, ph_hi; };
enum { I_XP = 0, I_XS, I_CA_CKV, I_CA_KR, I_CB_K, I_CB_V, I_CC_K, I_CC_V, I_AB_PRE, I_AB_POST, I_AB_WIN, I_AB_QN, I_AB_KVN, I_AB_WUQ, I_AB_WUKV, I_AB_REL, I_AB_WOUT,
       I_C_PRE, I_C_POST, I_C_WIN, I_C_SINKS, I_C_WOUT };

__device__ __forceinline__ void transpose_item(const GAS float* W, int K, int N, GAS bf16_t* WT, LAS float* scr, int item, int lane, int shift_nb = 1 << 30) {
    const int nblk = N / 32, kb = item / nblk, nb = item % nblk, k0 = 64 * kb, n0 = 32 * nb, rsh = nb >= shift_nb ? 32 : 0;
#pragma unroll 8
    for (int i = 0; i < 32; ++i) { const int kk = 2 * i + (lane >> 5); scr[kk * 33 + (lane & 31)] = __builtin_nontemporal_load(W + (size_t)(k0 + kk) * N + n0 + (lane & 31)); }
    asm volatile("s_waitcnt lgkmcnt(0)" ::: "memory");
    const int c = lane & 7;
#pragma unroll
    for (int j = 0; j < 4; ++j) { const int n = (lane >> 3) + 8 * j; const LAS float* s = scr + (8 * c) * 33 + n;
        u32x4 o; o.x = pk2(s[0 * 33], s[1 * 33]); o.y = pk2(s[2 * 33], s[3 * 33]); o.z = pk2(s[4 * 33], s[5 * 33]); o.w = pk2(s[6 * 33], s[7 * 33]);
        *(GAS u32x4*)(WT + (size_t)(rsh + n0 + n) * K + k0 + 8 * c) = o; }
    asm volatile("s_waitcnt lgkmcnt(0)" ::: "memory");
}
__device__ __forceinline__ void rms_row_to_bf16(const GAS float* xrow, const GAS float* gain, GAS bf16_t* orow, int lane) {
    const GAS f32x4* xr = (const GAS f32x4*)xrow + lane; const GAS f32x4* gr = (const GAS f32x4*)gain + lane;
    f32x4 v[4]; float s = 0.f;
#pragma unroll
    for (int j = 0; j < 4; ++j) { v[j] = xr[64 * j]; s += (v[j].x * v[j].x + v[j].y * v[j].y) + (v[j].z * v[j].z + v[j].w * v[j].w); }
    const float rstd = 1.0f / sqrtf(wave_sum(s) * (1.f / DM) + RMS_EPS);
    GAS u32x2* o8 = (GAS u32x2*)orow + lane;
#pragma unroll
    for (int j = 0; j < 4; ++j) { const f32x4 g = gr[64 * j]; u32x2 w; w.x = pk2(v[j].x * rstd * g.x, v[j].y * rstd * g.y); w.y = pk2(v[j].z * rstd * g.z, v[j].w * rstd * g.w); o8[64 * j] = w; }
}

__global__ void __launch_bounds__(512, 2) mega_fwd(Args a) {
    extern __shared__ __attribute__((aligned(16))) unsigned char lds_raw[];
    LAS unsigned char* lds = (LAS unsigned char*)lds_raw;
    cg::grid_group grid = cg::this_grid();
#define GIN(k) ((const GAS float*)a.in[k])
    const int G = gridDim.x, bx = blockIdx.x;
    constexpr int LDS_XB = 132 * 1024;
    if (threadIdx.x < 2) ((volatile LAS unsigned*)(lds + LDS_XB))[threadIdx.x] = 0u;
    __syncthreads();
    const XcdBarrier xbar = xcd_barrier_post((unsigned*)(a.ws + WS_CTL) + 1024, (volatile LAS unsigned*)(lds + LDS_XB));
#define PHASE_PTRS \
    int tid = threadIdx.x; asm volatile("" : "+v"(tid)); const int lane = tid & 63, wave = __builtin_amdgcn_readfirstlane(tid >> 6); (void)lane;   \
    const int gw = bx * 8 + wave, NGW = G * 8; (void)gw; (void)NGW; \
    const size_t gt = (size_t)bx * 512 + tid, NGT = (size_t)G * 512; (void)gt; (void)NGT; \
    GAS unsigned char* ws = (GAS unsigned char*)a.ws; GAS float* dout = (GAS float*)a.out; asm volatile("" : "+s"(ws), "+s"(dout));   \
    GAS unsigned* ctl = (GAS unsigned*)(ws + WS_CTL); (void)ctl; \
    GAS f32x2* ropeA = (GAS f32x2*)(ws + WS_ROPEA); GAS f32x2* ropeC = (GAS f32x2*)(ws + WS_ROPEC); (void)ropeA; (void)ropeC; \
    GAS bf16_t* WIN0 = (GAS bf16_t*)(ws + WS_WIN0); GAS bf16_t* WUQ = (GAS bf16_t*)(ws + WS_WUQ); GAS bf16_t* WUKV = (GAS bf16_t*)(ws + WS_WUKV); (void)WIN0; (void)WUQ; (void)WUKV; \
    GAS bf16_t* WOUT0 = (GAS bf16_t*)(ws + WS_WOUT0); GAS bf16_t* WIN1 = (GAS bf16_t*)(ws + WS_WIN1); GAS bf16_t* WOUT1 = (GAS bf16_t*)(ws + WS_WOUT1); (void)WOUT0; (void)WIN1; (void)WOUT1; \
    GAS bf16_t* KCS = (GAS bf16_t*)(ws + WS_KCS); GAS bf16_t* VCS = (GAS bf16_t*)(ws + WS_VCS); (void)KCS; (void)VCS; \
    GAS bf16_t* Z = (GAS bf16_t*)(ws + WS_Z); GAS bf16_t* KVB = (GAS bf16_t*)(ws + WS_KVB); GAS bf16_t* CACHEC = (GAS bf16_t*)(ws + WS_CACHEC); GAS bf16_t* KRC = (GAS bf16_t*)(ws + WS_KRC); (void)Z; (void)KVB; (void)CACHEC; (void)KRC; \
    GAS bf16_t* KBS = (GAS bf16_t*)(ws + WS_KBS); GAS bf16_t* VBS = (GAS bf16_t*)(ws + WS_VBS); (void)KBS; (void)VBS; \
    GAS bf16_t* Y = (GAS bf16_t*)(ws + WS_Y); GAS bf16_t* H1 = (GAS bf16_t*)(ws + WS_H1); (void)H1; GAS float* YP = (GAS float*)(ws + WS_YP); (void)YP; GAS bf16_t* XN1 = (GAS bf16_t*)(ws + WS_XN1); (void)Y; (void)XN1; \
    GAS bf16_t* XN0 = (GAS bf16_t*)((GAS unsigned char*)dout + DO_XN0); GAS bf16_t* QA = (GAS bf16_t*)((GAS unsigned char*)dout + DO_QA); (void)XN0; (void)QA;
    const int lo = a.ph_lo, hi = a.ph_hi;
    if (lo < 0) grid.sync();
#ifdef PROBE_G2
#define PROBE_GEMM_REP for (int rep_ = 0; rep_ < (a.ph_hi > 5 ? 2 : 1); ++rep_)
#else
#define PROBE_GEMM_REP
#endif
#ifdef PROBE_SYNC
#define EXTRA_SYNC() do { if (a.ph_hi > 5) xcd_barrier(xbar); } while (0)
#else
#define EXTRA_SYNC() do {} while (0)
#endif
#define IN(k) (lo <= (k) && (k) < hi)
#define SEAM(k) do { if (IN(k) && IN((k) + 1)) { xcd_barrier(xbar); EXTRA_SYNC(); } } while (0)

    if (IN(0)) {
        PHASE_PTRS
        LAS float* scr = (LAS float*)(lds + wave * 16384);
        constexpr int I0 = 16 * 101, I1 = 6 * 24, I2 = 4 * 32, I3 = 16 * 32, I4 = 16 * 72, I5 = 16 * 32;
        for (int it = gw; it < I0 + I1 + I2 + I3; it += NGW) {
            int r = it;
            if (r < I0) { transpose_item(GIN(I_AB_WIN), 1024, 3232, WIN0, scr, r, lane, 21); continue; } r -= I0;
            if (r < I1) { transpose_item(GIN(I_AB_WUQ), 384, 768, WUQ, scr, r, lane); continue; } r -= I1;
            if (r < I2) { transpose_item(GIN(I_AB_WUKV), 256, 1024, WUKV, scr, r, lane); continue; } r -= I2;
            transpose_item(GIN(I_AB_WOUT), 1024, 1024, WOUT0, scr, r, lane);
        }
        for (size_t i = gt; i < (size_t)96 * 1024 / 8; i += NGT) { const size_t rr = i >> 7; ((GAS u32x4*)(WIN0 + (size_t)(rr < 32 ? 672 + rr : 3264 + (rr - 32)) * 1024))[i & 127] = (u32x4){0u, 0u, 0u, 0u}; }
        for (size_t i = gt; i < (size_t)8192 * 16; i += NGT) {
            const int pos = (int)(i >> 4), j = (int)(i & 15);
            const float inv = exp2f(-(float)j * 1.18322304f);
            const float ang = (float)pos * inv;
            const f32x2 cs = {cosf(ang), sinf(ang)};
            ropeA[i] = cs; if ((j & 1) == 0) ropeC[(size_t)pos * 8 + (j >> 1)] = cs;
        }
        {
            f32x4 nx[4];
#define P0_LOAD(r) do { const GAS f32x4* xr_ = (const GAS f32x4*)((r) < MP ? GIN(I_XP) + (size_t)(r) * DM : GIN(I_XS) + (size_t)((r) - MP) * DM) + lane; \
                _Pragma("unroll") for (int j = 0; j < 4; ++j) nx[j] = __builtin_nontemporal_load(xr_ + 64 * j); } while (0)
            const GAS f32x4* gr = (const GAS f32x4*)GIN(I_AB_PRE) + lane;
            if (gw < MT) P0_LOAD(gw);
            for (int r = gw; r < MT; r += NGW) {
                f32x4 v[4]; float sq = 0.f;
#pragma unroll
                for (int j = 0; j < 4; ++j) { v[j] = nx[j]; sq += (v[j].x * v[j].x + v[j].y * v[j].y) + (v[j].z * v[j].z + v[j].w * v[j].w); }
                if (r + NGW < MT) P0_LOAD(r + NGW);
                const float rstd = 1.0f / sqrtf(wave_sum(sq) * (1.f / DM) + RMS_EPS);
                GAS u32x2* o8 = (GAS u32x2*)(XN0 + (size_t)r * DM) + lane;
#pragma unroll
                for (int j = 0; j < 4; ++j) { const f32x4 g = gr[64 * j]; o8[64 * j] = (u32x2){pk2(v[j].x * rstd * g.x, v[j].y * rstd * g.y), pk2(v[j].z * rstd * g.z, v[j].w * rstd * g.w)}; }
            }
#undef P0_LOAD
        }
        for (size_t i = gt; i < (size_t)8 * 4096 * 256 / 4; i += NGT) { const f32x4 v = __builtin_nontemporal_load((const GAS f32x4*)GIN(I_CA_CKV) + i); ((GAS u32x2*)CACHEC)[i] = (u32x2){pk2(v.x, v.y), pk2(v.z, v.w)}; }
    }
    SEAM(0);

    if (IN(1)) {
        PHASE_PTRS
        pg8::Gemm g{XN0, WIN0, MT, ZP, 1024, 1024, 1024}; pg8::StaticOrder S; S.init(MT, ZP, G, bx);
        pg8::EpiStrip<0> E{Z, ZP, (const GAS f32x4*)ropeA, (const GAS f32x4*)ropeC, dout, KCS, VCS};
        PROBE_GEMM_REP pg8::gemm_phase<pg8::EpiStrip<0>, true>(lds, g, S, E);
        const int nlate = 858 - 3 * G;
        if (nlate > 0 && nlate < G) {
            pg8::Gemm g2{CACHEC, WUKV, 32768, 1024, 256, 256, 256}; pg8::StaticOrder S2; S2.init(32768, 1024, G - nlate, bx - nlate);
            if (bx < nlate) S2.init_one(-2, 0);
            pg8::EpiStrip<2> E2{KVB + (size_t)MT * 1024, 1024, (const GAS f32x4*)ropeA, (const GAS f32x4*)ropeC, dout, KCS, VCS};
            pg8::gemm_phase<pg8::EpiStrip<2>, true>(lds, g2, S2, E2);
        }
    }
    SEAM(1);

    if (IN(2)) {
        PHASE_PTRS
        for (size_t i = gt; i < (size_t)8 * 4096 * 32 / 4; i += NGT) { const f32x4 v = __builtin_nontemporal_load((const GAS f32x4*)GIN(I_CA_KR) + i); ((GAS u32x2*)KRC)[i] = (u32x2){pk2(v.x, v.y), pk2(v.z, v.w)}; }
        for (size_t i = gt; i < (size_t)2 * 8 * 512 * 512 / 4; i += NGT) {
            const int which = (int)(i / (8 * 512 * 512 / 4)); const size_t e = (i % (8 * 512 * 512 / 4)) * 4; const int b = (int)(e >> 18), t = (int)((e >> 9) & 511), c = (int)(e & 511);
            const f32x4 v = __builtin_nontemporal_load((const GAS f32x4*)((const GAS float*)a.in[which ? I_CB_V : I_CB_K] + e));
            *(GAS u32x2*)((which ? VBS : KBS) + ((size_t)b * 576 + t) * 512 + c) = (u32x2){pk2(v.x, v.y), pk2(v.z, v.w)};
            if (t >= 64) __builtin_nontemporal_store(v, (GAS f32x4*)(dout + (which ? O_BV_S : O_BK_S) + ((size_t)b * 512 + t - 64) * 512 + c));
        }
        for (size_t i = gt; i < (size_t)2 * 8 * 128 * 128 / 4; i += NGT) {
            const int which = (int)(i / (8 * 128 * 128 / 4)); const size_t e = (i % (8 * 128 * 128 / 4)) * 4; const int b = (int)(e >> 14), t = (int)((e >> 7) & 127), c = (int)(e & 127);
            const f32x4 v = __builtin_nontemporal_load((const GAS f32x4*)((const GAS float*)a.in[which ? I_CC_V : I_CC_K] + e));
            *(GAS u32x2*)((which ? VCS : KCS) + ((size_t)b * 192 + t) * 128 + c) = (u32x2){pk2(v.x, v.y), pk2(v.z, v.w)};
            if (t >= 64) __builtin_nontemporal_store(v, (GAS f32x4*)(dout + (which ? O_CV_S : O_CK_S) + ((size_t)b * 128 + t - 64) * 128 + c));
        }
        unsigned nq[3]; u32x2 nc; unsigned nk;
#define P2_LOAD(r) do { const GAS bf16_t* z_ = Z + (size_t)(r) * ZP; _Pragma("unroll") for (int j = 0; j < 3; ++j) nq[j] = *(const GAS unsigned*)(z_ + 2 * lane + 128 * j); \
            nc = *(const GAS u32x2*)(z_ + ZC_CKV + 4 * lane); nk = *(const GAS unsigned*)(z_ + ZC_KR + 2 * (lane & 15)); } while (0)
        if (gw < MT) P2_LOAD(gw);
        for (int r = gw; r < MT; r += NGW) {
            GAS bf16_t* zr = Z + (size_t)r * ZP;
            const bool smp = r >= MP; const int b = smp ? (r - MP) >> 6 : r >> 13, t = smp ? (r - MP) & 63 : r & 8191;
            unsigned wv[3]; const u32x2 wc2 = nc; const unsigned wk = nk;
#pragma unroll
            for (int j = 0; j < 3; ++j) wv[j] = nq[j];
            if (r + NGW < MT) P2_LOAD(r + NGW);
            {
                float s = 0.f;
#pragma unroll
                for (int j = 0; j < 3; ++j) { const float x0 = bflo(wv[j]), x1 = bfhi(wv[j]); s += x0 * x0 + x1 * x1; }
                const float rstd = 1.0f / sqrtf(wave_sum(s) * (1.f / 384.f) + RMS_EPS);
#pragma unroll
                for (int j = 0; j < 3; ++j) { const f32x2 gq = *(const GAS f32x2*)(GIN(I_AB_QN) + 2 * lane + 128 * j);
                    *(GAS unsigned*)(zr + 2 * lane + 128 * j) = pk2(bflo(wv[j]) * rstd * gq.x, bfhi(wv[j]) * rstd * gq.y); }
            }
            {
                const u32x2 wv2 = wc2;
                const float x0 = bflo(wv2.x), x1 = bfhi(wv2.x), x2 = bflo(wv2.y), x3 = bfhi(wv2.y);
                const float rstd = 1.0f / sqrtf(wave_sum(x0 * x0 + x1 * x1 + x2 * x2 + x3 * x3) * (1.f / 256.f) + RMS_EPS);
                const f32x4 gk = *(const GAS f32x4*)(GIN(I_AB_KVN) + 4 * lane);
                const f32x4 c = {x0 * rstd * gk.x, x1 * rstd * gk.y, x2 * rstd * gk.z, x3 * rstd * gk.w};
                *(GAS u32x2*)(zr + ZC_CKV + 4 * lane) = (u32x2){pk2(c.x, c.y), pk2(c.z, c.w)};
                __builtin_nontemporal_store(c, (GAS f32x4*)(dout + (smp ? O_CKV_S + (size_t)(r - MP) * 256 : O_CKV_P + (size_t)r * 256) + 4 * lane));
            }
            if (lane < 16) {
                *(GAS f32x2*)(dout + (smp ? O_KR_S + (size_t)(r - MP) * 32 : O_KR_P + (size_t)r * 32) + 2 * lane) = (f32x2){bflo(wk), bfhi(wk)};
            }
            if (smp || t >= 7680) {
                const u32x4 kv = *(const GAS u32x4*)(zr + ZC_KB + 8 * lane), vv = *(const GAS u32x4*)(zr + ZC_VB + 8 * lane);
                GAS float* kd = dout + (smp ? O_BK_S + ((size_t)b * 512 + 448 + t) * 512 : O_BK_P + ((size_t)b * 512 + (t - 7680)) * 512) + 8 * lane;
                GAS float* vd = dout + (smp ? O_BV_S + ((size_t)b * 512 + 448 + t) * 512 : O_BV_P + ((size_t)b * 512 + (t - 7680)) * 512) + 8 * lane;
                *(GAS f32x4*)kd = (f32x4){bflo(kv.x), bfhi(kv.x), bflo(kv.y), bfhi(kv.y)}; *(GAS f32x4*)(kd + 4) = (f32x4){bflo(kv.z), bfhi(kv.z), bflo(kv.w), bfhi(kv.w)};
                *(GAS f32x4*)vd = (f32x4){bflo(vv.x), bfhi(vv.x), bflo(vv.y), bfhi(vv.y)}; *(GAS f32x4*)(vd + 4) = (f32x4){bflo(vv.z), bfhi(vv.z), bflo(vv.w), bfhi(vv.w)};
                if (smp) { *(GAS u32x4*)(KBS + ((size_t)b * 576 + 512 + t) * 512 + 8 * lane) = kv; *(GAS u32x4*)(VBS + ((size_t)b * 576 + 512 + t) * 512 + 8 * lane) = vv; }
            }
        }
    }
#undef P2_LOAD
    SEAM(2);

    if (IN(3)) {
        PHASE_PTRS
        { pg8::Gemm g{Z, WUQ, MT, 768, 384, ZP, 384}; pg8::StaticOrder S; S.init(MT, 768, G, bx);
          pg8::EpiStrip<1> E{QA, 768, (const GAS f32x4*)ropeA, (const GAS f32x4*)ropeC, dout, KCS, VCS};
          PROBE_GEMM_REP pg8::gemm_phase<pg8::EpiStrip<1>, true>(lds, g, S, E); }
        { pg8::Gemm g{Z + ZC_CKV, WUKV, MT, 1024, 256, ZP, 256}; pg8::StaticOrder S; S.init(MT, 1024, G, (bx + (G > 198 ? G - 198 : 0)) % G);
          pg8::EpiStrip<2> E{KVB, 1024, (const GAS f32x4*)ropeA, (const GAS f32x4*)ropeC, dout, KCS, VCS};
          PROBE_GEMM_REP pg8::gemm_phase<pg8::EpiStrip<2>, true>(lds, g, S, E); }
        if (!(858 - 3 * G > 0 && 858 - 3 * G < G))
        { pg8::Gemm g{CACHEC, WUKV, 32768, 1024, 256, 256, 256}; pg8::StaticOrder S; S.init(32768, 1024, G, (bx + 206) % G);
          pg8::EpiStrip<2> E{KVB + (size_t)MT * 1024, 1024, (const GAS f32x4*)ropeA, (const GAS f32x4*)ropeC, dout, KCS, VCS};
          PROBE_GEMM_REP pg8::gemm_phase<pg8::EpiStrip<2>, true>(lds, g, S, E); }
    }
    SEAM(3);

    if (IN(4)) {
        PHASE_PTRS
        const int probe_pass = 0;
        for (;;) {
            const int uq = att::unit_take(lds, att::unit_ask(ctl + 0));
            if (uq >= 576) break;
            const int u = uq < 64 ? 512 + uq : uq - 64;
            att::AUnit U; U.qpitch = 768; U.opitch = ZP; U.kpitch = 1024; U.qpos0 = 0; U.wchunk = 0; U.sink = 0.f; U.nostore = probe_pass;
            if (u < 512) {
                const int qb = 31 - (u >> 4), b = (u >> 3) & 1, h = u & 7; const size_t r0 = (size_t)b * 8192;
                U.t_lo = 0; U.t_hi = 4 * qb + 3; U.t_split = 1 << 30;
                U.k1 = KVB + r0 * 1024 + h * 128; U.v1 = U.k1 + 64; U.kr1 = Z + r0 * ZP + ZC_KR; U.krpitch1 = ZP;
                U.k2 = U.k1; U.v2 = U.v1; U.kr2 = U.kr1; U.krpitch2 = ZP;
                U.wactive = true; U.wt_lo = 0; U.wt_hi = 4 * qb + (wave & 3);
                const size_t qrow = r0 + 256 * qb + 64 * (wave & 3);
                U.q = QA + qrow * 768 + h * 96; U.o = Z + qrow * ZP + ZC_GA + h * 64; U.g = U.o;
            } else {
                const int v = u - 512, b = v >> 3, h = v & 7;
                U.t_lo = 0; U.t_hi = 64; U.t_split = 64;
                U.k1 = KVB + ((size_t)MT + (size_t)b * 4096) * 1024 + h * 128; U.v1 = U.k1 + 64; U.kr1 = KRC + (size_t)b * 4096 * 32; U.krpitch1 = 32;
                const size_t nrow = (size_t)MP + b * 64;
                U.k2 = KVB + nrow * 1024 + h * 128; U.v2 = U.k2 + 64; U.kr2 = Z + nrow * ZP + ZC_KR; U.krpitch2 = ZP;
                U.wactive = (wave & 3) == 0; U.wt_lo = 0; U.wt_hi = 64;
                const size_t qrow = nrow;
                U.q = QA + qrow * 768 + h * 96; U.o = Z + qrow * ZP + ZC_GA + h * 64; U.g = U.o;
            }
            att::attn_unit_mla(lds, U);
        }
        for (;;) {
            const int u = att::unit_take(lds, att::unit_ask(ctl + 64));
            if (u >= 576) break;
            att::AUnit U; U.qpitch = ZP; U.opitch = ZP; U.t_split = 1 << 30; U.sink = 0.f; U.krpitch1 = 0; U.krpitch2 = 0; U.nostore = 0;
            int h;
            if (u < 512) {
                const int qb = 31 - (u >> 4), b = (u >> 3) & 1; h = u & 7; const size_t r0 = (size_t)b * 8192;
                const int cq = 4 * qb + (wave >> 1);
                U.t_lo = max(0, 4 * qb - 8); U.t_hi = 4 * qb + 3; U.kpitch = ZP;
                U.k1 = Z + r0 * ZP + ZC_KB + h * 64; U.v1 = Z + r0 * ZP + ZC_VB + h * 64;
                U.wactive = true; U.wt_lo = max(0, cq - 8); U.wt_hi = cq; U.wchunk = cq; U.qpos0 = 64 * cq + 32 * (wave & 1);
                const size_t qrow = r0 + 256 * qb + 32 * wave;
                U.q = Z + qrow * ZP + ZC_QB + h * 64; U.o = (GAS bf16_t*)U.q; U.g = Z + qrow * ZP + ZC_GB + h * 64;
            } else {
                const int v = u - 512, b = v >> 3; h = v & 7;
                U.t_lo = 0; U.t_hi = 8; U.kpitch = 512;
                U.k1 = KBS + (size_t)b * 576 * 512 + h * 64; U.v1 = VBS + (size_t)b * 576 * 512 + h * 64;
                U.wactive = wave < 2; U.wt_lo = 0; U.wt_hi = 8; U.wchunk = 8; U.qpos0 = 512 + 32 * (wave & 1);
                const size_t qrow = (size_t)MP + b * 64 + 32 * (wave & 1);
                U.q = Z + qrow * ZP + ZC_QB + h * 64; U.o = (GAS bf16_t*)U.q; U.g = Z + qrow * ZP + ZC_GB + h * 64;
            }
            U.k2 = U.k1; U.v2 = U.v1; U.kr1 = U.k1; U.kr2 = U.k1;
            if (tid < 257) ((LAS float*)(lds + att::LDS_BIAS))[tid] = GIN(I_AB_REL)[h * 257 + tid] * LOG2E;
            att::attn_unit<1>(lds, U);
        }
    }
    SEAM(4);

    if (IN(5)) {
        PHASE_PTRS
        { pg8::Gemm g{Z + ZC_GA, WOUT0, MP, 1024, 1024, ZP, 1024}; pg8::StaticOrder S; S.init(MP, 1024, G, bx);
          pg8::EpiStrip<2> E{Y, 1024, (const GAS f32x4*)ropeA, (const GAS f32x4*)ropeC, dout, KCS, VCS};
          PROBE_GEMM_REP pg8::gemm_phase<pg8::EpiStrip<2>, true>(lds, g, S, E); }
        { const int kq = bx & 3, un = (bx >> 2) & 7;
          pg8::Gemm g{Z + ZC_GA + kq * 256, WOUT0 + kq * 256, MT, 1024, 256, ZP, 1024}; pg8::StaticOrder S; S.init_one(bx < 32 ? 64 + (un >> 2) : -2, un & 3);
          pg8::EpiF32 E{YP + (size_t)kq * 524288 - (size_t)MP * 1024, 1024};
          pg8::gemm_phase<pg8::EpiF32, true>(lds, g, S, E); }
        {
            constexpr int J4 = 16 * 72, J5 = 16 * 32;
            LAS float* scr = (LAS float*)(lds + wave * 16384);
            const int nwv = (G > 32 ? G - 32 : G) * 8, wv0 = (G > 32 ? bx - 32 : bx) * 8 + wave;
            if (wv0 >= 0) for (int it = wv0; it < J4 + J5; it += nwv) {
                if (it < J4) transpose_item(GIN(I_C_WIN), 1024, 2304, WIN1, scr, it, lane); else transpose_item(GIN(I_C_WOUT), 1024, 1024, WOUT1, scr, it - J4, lane); }
        }
    }
    SEAM(5);

#ifdef PROBE_R2
    for (int rr_ = 0; rr_ < (a.ph_hi > 5 ? 2 : 1); ++rr_)
#endif
    if (IN(6)) {
        PHASE_PTRS
        const GAS f32x4* pg = (const GAS f32x4*)GIN(I_AB_POST) + lane; const GAS f32x4* ng = (const GAS f32x4*)GIN(I_C_PRE) + lane;
        u32x2 ny[4]; f32x4 nx[4];
#define P6_LOAD(r) do { const GAS f32x4* xr_ = (const GAS f32x4*)((r) < MP ? GIN(I_XP) + (size_t)(r) * DM : GIN(I_XS) + (size_t)((r) - MP) * DM) + lane; \
            _Pragma("unroll") for (int j = 0; j < 4; ++j) nx[j] = __builtin_nontemporal_load(xr_ + 64 * j); \
            if ((r) < MP) { const GAS u32x2* yr_ = (const GAS u32x2*)(Y + (size_t)(r) * DM) + lane; _Pragma("unroll") for (int j = 0; j < 4; ++j) ny[j] = __builtin_nontemporal_load(yr_ + 64 * j); } \
            else { const GAS f32x4* pr_ = (const GAS f32x4*)(YP + (size_t)((r) - MP) * DM) + lane;     \
                _Pragma("unroll") for (int j = 0; j < 4; ++j) { const f32x4 t_ = (pr_[64 * j] + pr_[64 * j + 131072]) + (pr_[64 * j + 262144] + pr_[64 * j + 393216]); ny[j] = (u32x2){pk2(t_.x, t_.y), pk2(t_.z, t_.w)}; } } } while (0)
        if (gw < MT) P6_LOAD(gw);
        for (int r = gw; r < MT; r += NGW) {
            f32x4 v[4], x[4]; float s = 0.f;
#pragma unroll
            for (int j = 0; j < 4; ++j) { v[j] = (f32x4){bflo(ny[j].x), bfhi(ny[j].x), bflo(ny[j].y), bfhi(ny[j].y)}; x[j] = nx[j]; s += (v[j].x * v[j].x + v[j].y * v[j].y) + (v[j].z * v[j].z + v[j].w * v[j].w); }
            if (r + NGW < MT) P6_LOAD(r + NGW);
            const float rstd = 1.0f / sqrtf(wave_sum(s) * (1.f / DM) + RMS_EPS);
            float s2 = 0.f;
#pragma unroll
            for (int j = 0; j < 4; ++j) { v[j] = x[j] + v[j] * rstd * pg[64 * j]; s2 += (v[j].x * v[j].x + v[j].y * v[j].y) + (v[j].z * v[j].z + v[j].w * v[j].w); }
            const float rstd2 = 1.0f / sqrtf(wave_sum(s2) * (1.f / DM) + RMS_EPS);
            GAS u32x2* hr = (GAS u32x2*)(H1 + (size_t)r * DM) + lane; GAS u32x2* o8 = (GAS u32x2*)(XN1 + (size_t)r * DM) + lane;
#pragma unroll
            for (int j = 0; j < 4; ++j) { __builtin_nontemporal_store((u32x2){pk2(v[j].x, v[j].y), pk2(v[j].z, v[j].w)}, hr + 64 * j); const f32x4 g = ng[64 * j];
                o8[64 * j] = (u32x2){pk2(v[j].x * rstd2 * g.x, v[j].y * rstd2 * g.y), pk2(v[j].z * rstd2 * g.z, v[j].w * rstd2 * g.w)}; }
        }
#undef P6_LOAD
    }
    SEAM(6);

    if (IN(7)) {
        PHASE_PTRS
        pg8::Gemm g{XN1, WIN1, MT, Z1P, 1024, 1024, 1024}; pg8::StaticOrder S; S.init(MT, Z1P, G, bx);
        pg8::EpiStrip<3> E{Z, Z1P, (const GAS f32x4*)ropeA, (const GAS f32x4*)ropeC, dout, KCS, VCS};
        PROBE_GEMM_REP pg8::gemm_phase<pg8::EpiStrip<3>, true>(lds, g, S, E);
    }
    SEAM(7);

    if (IN(8)) {
        PHASE_PTRS
        for (int u = bx; u < 1056; u += G) {
            att::AUnit U; U.qpitch = Z1P; U.opitch = Z1P; U.t_split = 1 << 30; U.krpitch1 = 0; U.krpitch2 = 0; U.qpos0 = 0; U.wchunk = 0; U.nostore = 0;
            int qh; size_t qrow;
            if (u < 1024) {
                const int half = u & 1, hk = (u >> 1) & 1, b = (u >> 2) & 1, c = 127 - (u >> 3); const size_t r0 = (size_t)b * 8192;
                U.t_lo = max(0, c - 2); U.t_hi = c; U.kpitch = Z1P;
                U.k1 = Z + r0 * Z1P + Z1_K + hk * 64; U.v1 = Z + r0 * Z1P + Z1_V + hk * 64;
                qh = hk * 8 + half * 4 + (wave >> 1); qrow = r0 + 64 * c + 32 * (wave & 1);
            } else {
                const int v = u - 1024, half = v & 1, hk = (v >> 1) & 1, b = v >> 2;
                U.t_lo = 0; U.t_hi = 2; U.kpitch = 128;
                U.k1 = KCS + (size_t)b * 192 * 128 + hk * 64; U.v1 = VCS + (size_t)b * 192 * 128 + hk * 64;
                qh = hk * 8 + half * 4 + (wave >> 1); qrow = (size_t)MP + b * 64 + 32 * (wave & 1);
            }
            U.wactive = true; U.wt_lo = U.t_lo; U.wt_hi = U.t_hi;
            U.k2 = U.k1; U.v2 = U.v1; U.kr1 = U.k1; U.kr2 = U.k1;
            U.q = Z + qrow * Z1P + qh * 64; U.o = (GAS bf16_t*)U.q; U.g = Z + qrow * Z1P + Z1_G + qh * 64;
            U.sink = GIN(I_C_SINKS)[qh] * LOG2E;
            att::attn_unit<2>(lds, U);
        }
    }
    SEAM(8);

    if (IN(9)) {
        PHASE_PTRS
        { pg8::Gemm g{Z, WOUT1, MP, 1024, 1024, Z1P, 1024}; pg8::StaticOrder S; S.init(MP, 1024, G, bx);
          pg8::EpiStrip<2> E{Y, 1024, (const GAS f32x4*)ropeA, (const GAS f32x4*)ropeC, dout, KCS, VCS};
          PROBE_GEMM_REP pg8::gemm_phase<pg8::EpiStrip<2>, true>(lds, g, S, E); }
        { const int kq = bx & 3, un = (bx >> 2) & 7;
          pg8::Gemm g{Z + kq * 256, WOUT1 + kq * 256, MT, 1024, 256, Z1P, 1024}; pg8::StaticOrder S; S.init_one(bx < 32 ? 64 + (un >> 2) : -2, un & 3);
          pg8::EpiF32 E{YP + (size_t)kq * 524288 - (size_t)MP * 1024, 1024};
          pg8::gemm_phase<pg8::EpiF32, true>(lds, g, S, E); }
    }
    SEAM(9);

    if (IN(10)) {
        PHASE_PTRS
        const GAS f32x4* pg = (const GAS f32x4*)GIN(I_C_POST) + lane;
        u32x2 ny[4]; u32x2 nh[4];
#define P10_LOAD(r) do { const GAS u32x2* hr_ = (const GAS u32x2*)(H1 + (size_t)(r) * DM) + lane; \
            _Pragma("unroll") for (int j = 0; j < 4; ++j) nh[j] = __builtin_nontemporal_load(hr_ + 64 * j); \
            if ((r) < MP) { const GAS u32x2* yr_ = (const GAS u32x2*)(Y + (size_t)(r) * DM) + lane; _Pragma("unroll") for (int j = 0; j < 4; ++j) ny[j] = __builtin_nontemporal_load(yr_ + 64 * j); } \
            else { const GAS f32x4* pr_ = (const GAS f32x4*)(YP + (size_t)((r) - MP) * DM) + lane; \
                _Pragma("unroll") for (int j = 0; j < 4; ++j) { const f32x4 t_ = (pr_[64 * j] + pr_[64 * j + 131072]) + (pr_[64 * j + 262144] + pr_[64 * j + 393216]); ny[j] = (u32x2){pk2(t_.x, t_.y), pk2(t_.z, t_.w)}; } } } while (0)
        if (gw < MT) P10_LOAD(gw);
        for (int r = gw; r < MT; r += NGW) {
            f32x4 v[4], h[4]; float s = 0.f;
#pragma unroll
            for (int j = 0; j < 4; ++j) { v[j] = (f32x4){bflo(ny[j].x), bfhi(ny[j].x), bflo(ny[j].y), bfhi(ny[j].y)}; h[j] = (f32x4){bflo(nh[j].x), bfhi(nh[j].x), bflo(nh[j].y), bfhi(nh[j].y)}; s += (v[j].x * v[j].x + v[j].y * v[j].y) + (v[j].z * v[j].z + v[j].w * v[j].w); }
            if (r + NGW < MT) P10_LOAD(r + NGW);
            const float rstd = 1.0f / sqrtf(wave_sum(s) * (1.f / DM) + RMS_EPS);
            GAS f32x4* hr = (GAS f32x4*)(dout + O_Y + (size_t)r * DM) + lane;
#pragma unroll
            for (int j = 0; j < 4; ++j) __builtin_nontemporal_store(h[j] + v[j] * rstd * pg[64 * j], hr + 64 * j);
        }
#undef P10_LOAD
    }
#undef IN
#undef SEAM
}

extern "C" void kernel_launch(void* const* d_in, const int* in_sizes, int n_in, void* d_out, int out_size, void* d_ws, size_t ws_size, hipStream_t stream) {
    constexpr int LDS_BYTES = 136 * 1024;
    static int grid = 0;
    if (grid == 0) {
        if (n_in != 22 || ws_size < WS_END) { fprintf(stderr, "kernel_launch: unexpected n_in %d / ws_size %zu\n", n_in, ws_size); grid = -1; return; }
        int dev = 0, cus = 0, per_cu = 0;
        (void)hipGetDevice(&dev);
        (void)hipDeviceGetAttribute(&cus, hipDeviceAttributeMultiprocessorCount, dev);
        (void)hipFuncSetAttribute((const void*)mega_fwd, hipFuncAttributeMaxDynamicSharedMemorySize, LDS_BYTES);
        (void)hipOccupancyMaxActiveBlocksPerMultiprocessor(&per_cu, (const void*)mega_fwd, 512, LDS_BYTES);
        if (per_cu < 1) { fprintf(stderr, "kernel_launch: occupancy query says %d blocks per CU\n", per_cu); per_cu = 1; }
        grid = cus * per_cu;
        (void)hipGetLastError();
    }
    if (grid < 0) return;
    (void)hipMemsetAsync((char*)d_ws + WS_CTL, 0, 64 * 1024, stream);
    Args a{};
    for (int i = 0; i < 22; ++i) a.in[i] = (const float*)d_in[i];
    a.out = (float*)d_out; a.ws = (unsigned char*)d_ws; a.ph_lo = 0; a.ph_hi = 11;
    void* args[] = {&a};
    hipError_t e = hipLaunchCooperativeKernel((const void*)mega_fwd, dim3(grid), dim3(512), args, LDS_BYTES, stream);
    if (e != hipSuccess) fprintf(stderr, "kernel_launch: cooperative launch failed: %s (grid %d)\n", hipGetErrorString(e), grid);
}
```
